# Optimizing an MI355X kernel written in HIP

```python
import math
import jax, jax.numpy as jnp
from jax import lax
import numpy as np

D_MODEL = 1024
BATCH = 4
SEQ = 4096
DEPTH = 1

D_MIX = D_MODEL
D_ATTN = D_MIX // 2
D_CONV = D_MIX - D_ATTN
HEAD_DIM = 64
N_HEADS = D_ATTN // HEAD_DIM
N_KV_HEADS = 2
GQA_GROUP = N_HEADS // N_KV_HEADS
WINDOW = 128
BLOCK = 128
NUM_BUCKETS = 32
MAX_DISTANCE = 128
CONV_WIDTH = 31
CONV_GROUPS = 8
D_Q = N_HEADS * HEAD_DIM
D_KV = N_KV_HEADS * HEAD_DIM
D_IN = D_Q + 2 * D_KV + D_ATTN + 2 * D_CONV + D_CONV
EPS = 1e-6
NEG_INF = -1e30

kernel_name = "hymba_conformer_swa_sink_block"


def rmsnorm(x, w, eps=EPS):
    xf = x.astype(jnp.float32)
    y = xf * lax.rsqrt(jnp.mean(xf * xf, axis=-1, keepdims=True) + eps)
    return (y * w.astype(jnp.float32)).astype(x.dtype)


def layernorm(x, w, b, eps=1e-5):
    xf = x.astype(jnp.float32)
    mu = jnp.mean(xf, axis=-1, keepdims=True)
    var = jnp.mean(jnp.square(xf - mu), axis=-1, keepdims=True)
    y = (xf - mu) * lax.rsqrt(var + eps)
    return (y * w.astype(jnp.float32) + b.astype(jnp.float32)).astype(x.dtype)


def t5_causal_bucket(dist):
    n = jnp.maximum(dist, 0)
    max_exact = NUM_BUCKETS // 2
    nf = jnp.maximum(n, 1).astype(jnp.float32)
    large = max_exact + (jnp.log(nf / max_exact) / math.log(MAX_DISTANCE / max_exact)
                         * (NUM_BUCKETS - max_exact)).astype(jnp.int32)
    large = jnp.minimum(large, NUM_BUCKETS - 1)
    return jnp.where(n < max_exact, n, large)


def sliding_window_attention(q, k, v, rel_bias, sinks):
    B, S = q.shape[0], q.shape[1]
    nb = S // BLOCK
    scale = HEAD_DIM ** -0.5
    qb = q.reshape(B, nb, BLOCK, N_KV_HEADS, GQA_GROUP, HEAD_DIM)
    pad = ((0, 0), (BLOCK, 0), (0, 0), (0, 0))
    kp = jnp.pad(k, pad).reshape(B, nb + 1, BLOCK, N_KV_HEADS, HEAD_DIM)
    vp = jnp.pad(v, pad).reshape(B, nb + 1, BLOCK, N_KV_HEADS, HEAD_DIM)
    kwin = jnp.concatenate([kp[:, :-1], kp[:, 1:]], axis=2)
    vwin = jnp.concatenate([vp[:, :-1], vp[:, 1:]], axis=2)

    logits = jnp.einsum('bnqkgd,bnskd->bnkgqs', qb, kwin,
                        preferred_element_type=jnp.float32) * scale
    qi = jnp.arange(BLOCK)[:, None]
    sj = jnp.arange(2 * BLOCK)[None, :]
    dist = qi + BLOCK - sj
    band = (dist >= 0) & (dist < WINDOW)
    bias = rel_bias.astype(jnp.float32)[t5_causal_bucket(dist)]
    bias = bias.transpose(2, 0, 1).reshape(N_KV_HEADS, GQA_GROUP, BLOCK, 2 * BLOCK)
    valid_key = (jnp.arange(nb)[:, None] > 0) | (sj >= BLOCK)
    mask = band[None, :, :] & valid_key[:, None, :]
    logits = jnp.where(mask[None, :, None, None, :, :], logits + bias[None, None], NEG_INF)

    sink = sinks.astype(jnp.float32).reshape(1, 1, N_KV_HEADS, GQA_GROUP, 1, 1)
    m = jnp.maximum(jnp.max(logits, axis=-1, keepdims=True), sink)
    p = jnp.exp(logits - m)
    denom = jnp.sum(p, axis=-1, keepdims=True) + jnp.exp(sink - m)
    probs = (p / denom).astype(v.dtype)
    out = jnp.einsum('bnkgqs,bnskd->bnqkgd', probs, vwin)
    return out.reshape(B, S, D_ATTN)


def conformer_conv(u_glu, dw_w, dw_b, ln_w, ln_b):
    a, g = jnp.split(u_glu, 2, axis=-1)
    u = a * jax.nn.sigmoid(g)
    y = lax.conv_general_dilated(
        u, dw_w[:, None, :].astype(u.dtype), window_strides=(1,),
        padding=[(CONV_WIDTH - 1, 0)], dimension_numbers=('NWC', 'WIO', 'NWC'),
        feature_group_count=D_CONV) + dw_b
    y = layernorm(y, ln_w, ln_b)
    return jax.nn.silu(y)


def hybrid_layer(x, norm_w, w_in, q_norm_w, k_norm_w, sinks, dw_w, dw_b,
                 ln_w, ln_b, w_out, rel_bias):
    B, S, _ = x.shape
    h = rmsnorm(x, norm_w)
    proj = h @ w_in
    splits = np.cumsum([D_Q, D_KV, D_KV, D_ATTN, 2 * D_CONV])
    q, k, v, z_attn, u_glu, z_conv = jnp.split(proj, splits, axis=-1)

    q = rmsnorm(q.reshape(B, S, N_KV_HEADS, GQA_GROUP, HEAD_DIM), q_norm_w)
    k = rmsnorm(k.reshape(B, S, N_KV_HEADS, HEAD_DIM), k_norm_w)
    v = v.reshape(B, S, N_KV_HEADS, HEAD_DIM)
    y_attn = sliding_window_attention(q, k, v, rel_bias, sinks) * jax.nn.silu(z_attn)

    y_conv = conformer_conv(u_glu, dw_w, dw_b, ln_w, ln_b) * jax.nn.silu(z_conv)

    y = jnp.concatenate([y_attn, y_conv], axis=-1) @ w_out
    return x + y


def setup_inputs(seed: int = 0) -> dict:
    key = jax.random.key(seed)
    ks = jax.random.split(key, 12)
    L = DEPTH
    f = jnp.float32
    return {
        "x": jax.random.normal(ks[0], (BATCH, SEQ, D_MODEL), f),
        "norm_w": 1.0 + 0.05 * jax.random.normal(ks[1], (L, D_MODEL), f),
        "w_in": jax.random.normal(ks[2], (L, D_MODEL, D_IN), f) * D_MODEL ** -0.5,
        "q_norm_w": 1.0 + 0.05 * jax.random.normal(ks[3], (L, HEAD_DIM), f),
        "k_norm_w": 1.0 + 0.05 * jax.random.normal(ks[4], (L, HEAD_DIM), f),
        "sinks": 0.5 * jax.random.normal(ks[5], (L, N_HEADS), f),
        "dw_w": jax.random.normal(ks[6], (L, CONV_WIDTH, D_CONV), f) * CONV_WIDTH ** -0.5,
        "dw_b": 0.02 * jax.random.normal(ks[7], (L, D_CONV), f),
        "ln_w": 1.0 + 0.05 * jax.random.normal(ks[8], (L, D_CONV), f),
        "ln_b": 0.02 * jax.random.normal(ks[9], (L, D_CONV), f),
        "w_out": jax.random.normal(ks[10], (L, D_MIX, D_MODEL), f) * D_MIX ** -0.5,
        "rel_bias": 0.5 * jax.random.normal(ks[11], (NUM_BUCKETS, N_HEADS), f),
    }


def reference(x, norm_w, w_in, q_norm_w, k_norm_w, sinks, dw_w, dw_b,
              ln_w, ln_b, w_out, rel_bias):
    for l in range(DEPTH):
        x = hybrid_layer(x, norm_w[l], w_in[l], q_norm_w[l], k_norm_w[l], sinks[l],
                         dw_w[l], dw_b[l], ln_w[l], ln_b[l], w_out[l], rel_bias)
    return x
```

```cpp
#include <hip/hip_runtime.h>
#include <cstdio>
#include <cstdint>

typedef unsigned short bf16;
constexpr int D_MODEL = 1024, BATCH = 4, SEQ = 4096, M = BATCH * SEQ;
constexpr int HEAD_DIM = 64, N_HEADS = 8, N_KV = 2, GQA = 4, WINDOW = 128;
constexpr int D_ATTN = 512, D_CONV = 512, CONVW = 31;
constexpr int D_IN = 2816;
constexpr int C_Q = 0, C_K = 512, C_V = 640, C_ZA = 768, C_A = 1280, C_G = 1792, C_ZC = 2304;
constexpr float EPS = 1e-6f, LN_EPS = 1e-5f;
constexpr float LOG2E = 1.4426950408889634f;

constexpr size_t MiB = 1u << 20;
constexpr size_t WS_CTL = 0;
constexpr size_t WS_WIN = 2 * MiB;
constexpr size_t WS_WOUT = 8 * MiB;
constexpr size_t WS_XN = 16 * MiB;
constexpr size_t WS_P = 48 * MiB;
constexpr size_t WS_Y = 136 * MiB;
constexpr size_t WS_YC = 168 * MiB;
constexpr size_t WS_END = 200 * MiB;

__device__ __forceinline__ unsigned f2bf(float f) { unsigned u = __builtin_bit_cast(unsigned, f); return (u + 0x7fffu + ((u >> 16) & 1u)) >> 16; }
__device__ __forceinline__ float bf2f(bf16 b) { return __builtin_bit_cast(float, (unsigned)b << 16); }

__global__ void nv_transpose(const float* __restrict__ W, int K, int N, bf16* __restrict__ WT) {
    const int idx = blockIdx.x * blockDim.x + threadIdx.x;
    if (idx >= K * N) return;
    const int n = idx / K, k = idx % K;
    WT[(size_t)n * K + k] = (bf16)f2bf(W[(size_t)k * N + n]);
}
__global__ void nv_rmsnorm(const float* __restrict__ x, const float* __restrict__ w, bf16* __restrict__ xn) {
    const int row = blockIdx.x * (blockDim.x / 64) + (threadIdx.x >> 6), lane = threadIdx.x & 63;
    if (row >= M) return;
    const float* xr = x + (size_t)row * D_MODEL;
    float s = 0.f;
    for (int c = lane; c < D_MODEL; c += 64) s += xr[c] * xr[c];
    for (int o = 1; o < 64; o <<= 1) s += __shfl_xor(s, o);
    const float rs = 1.0f / sqrtf(s * (1.0f / D_MODEL) + EPS);
    for (int c = lane; c < D_MODEL; c += 64) xn[(size_t)row * D_MODEL + c] = (bf16)f2bf(xr[c] * rs * w[c]);
}
template <int MODE>
__global__ void nv_gemm(const bf16* __restrict__ A, const bf16* __restrict__ Bt, int Mr, int N, int K, bf16* __restrict__ Cb, float* __restrict__ Cf, const float* __restrict__ res) {
    __shared__ float As[16][65], Bs[16][65];
    const int tx = threadIdx.x & 15, ty = threadIdx.x >> 4;
    const int m0 = blockIdx.y * 64, n0 = blockIdx.x * 64;
    float acc[4][4] = {};
    for (int k0 = 0; k0 < K; k0 += 16) {
        for (int i = threadIdx.x; i < 64 * 16; i += 256) { const int r = i >> 4, c = i & 15; As[c][r] = bf2f(A[(size_t)(m0 + r) * K + k0 + c]); Bs[c][r] = bf2f(Bt[(size_t)(n0 + r) * K + k0 + c]); }
        __syncthreads();
#pragma unroll
        for (int kk = 0; kk < 16; ++kk) {
            float a[4], b[4];
#pragma unroll
            for (int i = 0; i < 4; ++i) { a[i] = As[kk][ty * 4 + i]; b[i] = Bs[kk][tx * 4 + i]; }
#pragma unroll
            for (int i = 0; i < 4; ++i)
#pragma unroll
                for (int j = 0; j < 4; ++j) acc[i][j] += a[i] * b[j];
        }
        __syncthreads();
    }
#pragma unroll
    for (int i = 0; i < 4; ++i)
#pragma unroll
        for (int j = 0; j < 4; ++j) {
            const size_t o = (size_t)(m0 + ty * 4 + i) * N + n0 + tx * 4 + j;
            if (MODE == 0) Cb[o] = (bf16)f2bf(acc[i][j]); else Cf[o] = res[o] + acc[i][j];
        }
}
__device__ __forceinline__ int t5_bucket(int dist) {
    if (dist < 16) return dist;
    const float nf = (float)dist;
    int large = 16 + (int)(logf(nf / 16.0f) / 2.0794415416798357f * 16.0f);
    return large < 31 ? large : 31;
}
__device__ __forceinline__ float silu_f(float z) { return z / (1.0f + __expf(-z)); }
__global__ void __launch_bounds__(256) nv_attn(const bf16* __restrict__ P, const float* __restrict__ qnw, const float* __restrict__ knw, const float* __restrict__ sinks, const float* __restrict__ relb, bf16* __restrict__ Y) {
    const int idx = blockIdx.x * blockDim.x + threadIdx.x;
    if (idx >= M * N_HEADS) return;
    const int h = idx % N_HEADS, row = idx / N_HEADS, t = row % SEQ, kvh = h / GQA;
    const bf16* pr = P + (size_t)row * D_IN;
    float q[64]; float ss = 0.f;
#pragma unroll
    for (int d = 0; d < 64; ++d) { q[d] = bf2f(pr[C_Q + h * 64 + d]); ss += q[d] * q[d]; }
    const float rs = 1.0f / sqrtf(ss / 64.0f + EPS);
#pragma unroll
    for (int d = 0; d < 64; ++d) q[d] = q[d] * rs * qnw[d];
    float m = sinks[h], l = 1.0f; float o[64];
#pragma unroll
    for (int d = 0; d < 64; ++d) o[d] = 0.f;
    const int klo = t - (WINDOW - 1) < 0 ? 0 : t - (WINDOW - 1);
    for (int kp = klo; kp <= t; ++kp) {
        const bf16* kr = P + (size_t)(row - t + kp) * D_IN;
        float ks = 0.f, dot = 0.f;
#pragma unroll
        for (int d = 0; d < 64; ++d) { const float kv = bf2f(kr[C_K + kvh * 64 + d]); ks += kv * kv; dot += q[d] * kv * knw[d]; }
        const float krs = 1.0f / sqrtf(ks / 64.0f + EPS);
        const float logit = dot * krs * 0.125f + relb[t5_bucket(t - kp) * N_HEADS + h];
        const float mn = fmaxf(m, logit), f = __expf(m - mn), p = __expf(logit - mn);
        l = l * f + p;
#pragma unroll
        for (int d = 0; d < 64; ++d) o[d] = o[d] * f + p * bf2f(kr[C_V + kvh * 64 + d]);
        m = mn;
    }
#pragma unroll
    for (int d = 0; d < 64; ++d) {
        const float z = bf2f(pr[C_ZA + h * 64 + d]);
        Y[(size_t)row * D_MODEL + h * 64 + d] = (bf16)f2bf(o[d] / l * silu_f(z));
    }
}
__global__ void nv_conv(const bf16* __restrict__ P, const float* __restrict__ dww, const float* __restrict__ dwb, float* __restrict__ yc) {
    const int idx = blockIdx.x * blockDim.x + threadIdx.x;
    if (idx >= M * D_CONV) return;
    const int c = idx % D_CONV, row = idx / D_CONV, t = row % SEQ;
    float acc = dwb[c];
    for (int j = 0; j < CONVW; ++j) {
        const int tt = t - (CONVW - 1) + j;
        if (tt < 0) continue;
        const bf16* pr = P + (size_t)(row - t + tt) * D_IN;
        const float a = bf2f(pr[C_A + c]), g = bf2f(pr[C_G + c]);
        acc += a / (1.0f + __expf(-g)) * dww[j * D_CONV + c];
    }
    yc[(size_t)row * D_CONV + c] = acc;
}
__global__ void nv_ln(const float* __restrict__ yc, const bf16* __restrict__ P, const float* __restrict__ lnw, const float* __restrict__ lnb, bf16* __restrict__ Y) {
    const int row = blockIdx.x * (blockDim.x / 64) + (threadIdx.x >> 6), lane = threadIdx.x & 63;
    if (row >= M) return;
    const float* yr = yc + (size_t)row * D_CONV;
    float v[8]; float s = 0.f;
    for (int i = 0; i < 8; ++i) { v[i] = yr[lane + 64 * i]; s += v[i]; }
    for (int o = 1; o < 64; o <<= 1) s += __shfl_xor(s, o);
    const float mu = s / D_CONV; float q = 0.f;
    for (int i = 0; i < 8; ++i) { const float d = v[i] - mu; q += d * d; }
    for (int o = 1; o < 64; o <<= 1) q += __shfl_xor(q, o);
    const float rstd = 1.0f / sqrtf(q / D_CONV + LN_EPS);
    for (int i = 0; i < 8; ++i) {
        const int c = lane + 64 * i;
        const float yv = (v[i] - mu) * rstd * lnw[c] + lnb[c];
        const float z = bf2f(P[(size_t)row * D_IN + C_ZC + c]);
        Y[(size_t)row * D_MODEL + D_ATTN + c] = (bf16)f2bf(silu_f(yv) * silu_f(z));
    }
}

extern "C" void kernel_launch(void* const* d_in, const int* in_sizes, int n_in, void* d_out, int out_size, void* d_ws, size_t ws_size, hipStream_t stream) {
    const float* x = (const float*)d_in[0]; const float* norm_w = (const float*)d_in[1]; const float* w_in = (const float*)d_in[2];
    const float* qnw = (const float*)d_in[3]; const float* knw = (const float*)d_in[4]; const float* sinks = (const float*)d_in[5];
    const float* dww = (const float*)d_in[6]; const float* dwb = (const float*)d_in[7]; const float* lnw = (const float*)d_in[8]; const float* lnb = (const float*)d_in[9];
    const float* w_out = (const float*)d_in[10]; const float* relb = (const float*)d_in[11];
    if (n_in != 12 || in_sizes[0] != M * D_MODEL || out_size != M * D_MODEL || ws_size < WS_END) { fprintf(stderr, "kernel_launch: unexpected shapes\n"); return; }
    unsigned char* ws = (unsigned char*)d_ws;
    bf16* WIN = (bf16*)(ws + WS_WIN); bf16* WOUT = (bf16*)(ws + WS_WOUT); bf16* XN = (bf16*)(ws + WS_XN); bf16* P = (bf16*)(ws + WS_P); bf16* Y = (bf16*)(ws + WS_Y);
    float* YC = (float*)(ws + WS_YC);
    hipLaunchKernelGGL(nv_transpose, dim3((D_MODEL * D_IN + 255) / 256), dim3(256), 0, stream, w_in, D_MODEL, D_IN, WIN);
    hipLaunchKernelGGL(nv_transpose, dim3((D_MODEL * D_MODEL + 255) / 256), dim3(256), 0, stream, w_out, D_MODEL, D_MODEL, WOUT);
    hipLaunchKernelGGL(nv_rmsnorm, dim3(M / 4), dim3(256), 0, stream, x, norm_w, XN);
    hipLaunchKernelGGL(nv_gemm<0>, dim3(D_IN / 64, M / 64), dim3(256), 0, stream, XN, WIN, M, D_IN, D_MODEL, P, (float*)nullptr, (const float*)nullptr);
    hipLaunchKernelGGL(nv_attn, dim3(M * N_HEADS / 256), dim3(256), 0, stream, P, qnw, knw, sinks, relb, Y);
    hipLaunchKernelGGL(nv_conv, dim3(M * D_CONV / 256), dim3(256), 0, stream, P, dww, dwb, YC);
    hipLaunchKernelGGL(nv_ln, dim3(M / 4), dim3(256), 0, stream, YC, P, lnw, lnb, Y);
    hipLaunchKernelGGL(nv_gemm<1>, dim3(D_MODEL / 64, M / 64), dim3(256), 0, stream, Y, WOUT, M, D_MODEL, D_MODEL, (bf16*)nullptr, (float*)d_out, x);
}
```

```cpp
#include <hip/hip_runtime.h>
#include <cstdio>
#include <cstdint>
namespace pg8 {
#define PG8_LAS __attribute__((address_space(3)))
typedef unsigned short bf16_t;
typedef short bf16x8 __attribute__((ext_vector_type(8)));
typedef float f32x4 __attribute__((ext_vector_type(4)));
typedef unsigned u32x4 __attribute__((ext_vector_type(4)));
constexpr int BM = 256, BK = 64, HALF = 128, HTB = HALF * BK * 2  , STAGE_BYTES = 8 * HTB, NXCD = 8, WGM = 8;

__host__ __device__ __forceinline__ int lds_byte(int r, int c) { const int st = (r >> 4) * 2 + (c >> 5), rr = r & 15, cc = c & 31, ob = rr * 64 + cc * 2; return st * 1024 + (ob ^ (((ob >> 9) & 1) << 5)); }
__host__ __device__ __forceinline__ void stage_rc(int b, int& R, int& C) { const int st = b / 1024, sb = b % 1024, swz = sb ^ (((sb >> 9) & 1) << 5); R = (st >> 1) * 16 + swz / 64; C = (st & 1) * 32 + (swz % 64) / 2; }
__host__ __device__ __forceinline__ int perm32(int rho) { const int n = rho >> 4, i = rho & 15; return 8 * (i >> 2) + 4 * n + (i & 3); }

struct Unit { int pm, pn; };
struct Gemm { const bf16_t* A; const bf16_t* Bt; int M, N, K; };

struct StaticOrder {
    int nM, nN, nwg, G, c;
    __host__ __device__ void init(int M, int N, int G_, int c_) { nM = M / BM; nN = N / BM; nwg = nM * nN; G = G_; c = c_; }
    __host__ __device__ bool next(int i, Unit& u) const {
        const long L = (long)i * G + c; if (L >= nwg) return false;
        int wgid = (int)L; { const int q = nwg / NXCD, r = nwg % NXCD, xcd = wgid % NXCD, off = wgid / NXCD; wgid = (xcd < r ? xcd * (q + 1) : r * (q + 1) + (xcd - r) * q) + off; }
        const int nig = WGM * nN, gid = wgid / nig, fm = gid * WGM, gsz = (nM - fm) < WGM ? (nM - fm) : WGM;
        u.pm = fm + ((wgid % nig) % gsz); u.pn = (wgid % nig) / gsz; return true;
    }
    __device__ __forceinline__ void a_ready(const Unit&) const {}
    __device__ __forceinline__ void done(const Unit&) const {}
};

__device__ __forceinline__ unsigned cvt_pk_bf16(float lo, float hi) { unsigned r; asm volatile("v_cvt_pk_bf16_f32 %0, %1, %2" : "=v"(r) : "v"(lo), "v"(hi)); return r; }
typedef float f32x2 __attribute__((ext_vector_type(2)));
__device__ __forceinline__ f32x2 gelu_pk(f32x2 v) {
    const f32x2 av = __builtin_elementwise_abs(v), d = av * 0.2316418882f + 1.0f;
    f32x2 t; t.x = __builtin_amdgcn_rcpf(d.x); t.y = __builtin_amdgcn_rcpf(d.y);
    f32x2 q = t * 0.5307027145f + (-0.7265760135f); q = q * t + 0.7107068705f; q = q * t + (-0.142248368f); q = q * t + 0.127414796f; q = q * t;
    const f32x2 s = (v * v) * (-0.72134752044f);
    f32x2 e; e.x = __builtin_amdgcn_exp2f(s.x); e.y = __builtin_amdgcn_exp2f(s.y);
    const f32x2 m = v * (q * e), r = v - m;
    f32x2 o; o.x = v.x < 0.f ? m.x : r.x; o.y = v.y < 0.f ? m.y : r.y; return o;
}

template <int ACT  > struct EpiBf16 {
    static constexpr bool PERM = true, AFTER_DRAIN = false; static_assert(ACT == 0 || ACT == 1, "EpiBf16: ACT is 0 (none) or 1 (gelu_pk)");
    bf16_t* O; int ldc; const float* bias; int split_cols; size_t split_stride; float scale0;
    __device__ __forceinline__ void operator()(const f32x4 (&acc)[2][2][4][2], const Unit& u, int wr, int wc, int fr, int fq) const {
        const int row0 = u.pm * BM + wr * 64 + fr; int colt = u.pn * BM; bf16_t* base = O;
        float sc = 1.f; if (split_cols) { const int t = colt / split_cols; base += (size_t)t * split_stride; colt -= t * split_cols; if (t == 0) sc = scale0; }
        const int col0 = colt + wc * 32 + 8 * fq, bcol0 = u.pn * BM + wc * 32 + 8 * fq;
        f32x4 bv[2][2];
#pragma unroll
        for (int bj = 0; bj < 2; ++bj)
#pragma unroll
            for (int n = 0; n < 2; ++n) bv[bj][n] = bias ? *(const f32x4*)(bias + bcol0 + bj * HALF + 4 * n) : (f32x4){0.f, 0.f, 0.f, 0.f};
#pragma unroll
        for (int ai = 0; ai < 2; ++ai)
#pragma unroll
            for (int m = 0; m < 4; ++m) { bf16_t* rowp = base + (size_t)(row0 + ai * HALF + m * 16) * ldc + col0;
#pragma unroll
                for (int bj = 0; bj < 2; ++bj) { f32x4 v0 = acc[ai][bj][m][0] + bv[bj][0], v1 = acc[ai][bj][m][1] + bv[bj][1];
                    if (ACT == 1) { f32x2 a = gelu_pk((f32x2){v0[0], v0[1]}), b = gelu_pk((f32x2){v0[2], v0[3]}), c = gelu_pk((f32x2){v1[0], v1[1]}), d = gelu_pk((f32x2){v1[2], v1[3]});
                        v0 = (f32x4){a.x, a.y, b.x, b.y}; v1 = (f32x4){c.x, c.y, d.x, d.y}; }
                    v0 = v0 * sc; v1 = v1 * sc; u32x4 w; w.x = cvt_pk_bf16(v0[0], v0[1]); w.y = cvt_pk_bf16(v0[2], v0[3]); w.z = cvt_pk_bf16(v1[0], v1[1]); w.w = cvt_pk_bf16(v1[2], v1[3]);
                    *(u32x4*)(rowp + bj * HALF) = w; } }
    }
};
struct EpiResF32 {
    static constexpr bool PERM = false, AFTER_DRAIN = false;
    float* C; const float* R; int ldc;
    __device__ __forceinline__ void operator()(const f32x4 (&acc)[2][2][4][2], const Unit& u, int wr, int wc, int fr, int fq) const {
        const int row0 = u.pm * BM + wr * 64 + fr, col0 = u.pn * BM + wc * 32 + 4 * fq;
#pragma unroll
        for (int ai = 0; ai < 2; ++ai)
#pragma unroll
            for (int m = 0; m < 4; ++m) { const size_t off = (size_t)(row0 + ai * HALF + m * 16) * ldc + col0;
                f32x4 rv[2][2];
#pragma unroll
                for (int bj = 0; bj < 2; ++bj)
#pragma unroll
                    for (int n = 0; n < 2; ++n) rv[bj][n] = *(const f32x4*)(R + off + bj * HALF + n * 16);
#pragma unroll
                for (int bj = 0; bj < 2; ++bj)
#pragma unroll
                    for (int n = 0; n < 2; ++n) *(f32x4*)(C + off + bj * HALF + n * 16) = rv[bj][n] + acc[ai][bj][m][n];
                if (m & 1) asm volatile("" ::: "memory"); }
    }
};
template <class Epi, class Sched, bool ALIGN_EPI = false, bool SP2 = false>
__device__ __forceinline__ void gemm_phase(PG8_LAS unsigned char* lds, const Gemm g, const Sched& S, const Epi& E) {
    const int tid = threadIdx.x, wid = __builtin_amdgcn_readfirstlane(tid >> 6), lane = tid & 63, wr = wid >> 2, wc = wid & 3, fr = lane & 15, fq = lane >> 4;
    const int K = g.K, nt = K / BK;
    unsigned voffA[2], voffB[2];
#pragma unroll
    for (int i = 0; i < 2; ++i) { int R, C; stage_rc(tid * 16 + i * 8192, R, C); const int Rb = Epi::PERM ? ((R & ~31) + perm32(R & 31)) : R;
        voffA[i] = (unsigned)(R * K + C) * 2u; voffB[i] = (unsigned)(Rb * K + C) * 2u; }
    const size_t kstep = (size_t)(BK * 2);
    const size_t hstep = (size_t)HALF * K * 2;
    const size_t tstep = 2 * hstep;
    const unsigned ldsw = (unsigned)wid * 1024u;
    const int aoff = lds_byte(wr * 64 + fr, fq * 8), boff = lds_byte(wc * 32 + fr, fq * 8);
#define PG8_SA(b, h) (((b) * 2 + (h)) * HTB)
#define PG8_SB(b, h) ((4 + (b) * 2 + (h)) * HTB)
#define PG8_STAGE(bufoff, gbase, voff) do { _Pragma("unroll") for (int _i = 0; _i < 2; ++_i) \
        __builtin_amdgcn_global_load_lds((const unsigned*)((const char*)(gbase) + (voff)[_i]), (PG8_LAS unsigned*)(lds + (bufoff) + ldsw + _i * 8192), 16, 0, 0); } while (0)
#define PG8_LDA(dst, b, h) do { _Pragma("unroll") for (int m = 0; m < 4; ++m) _Pragma("unroll") for (int k = 0; k < 2; ++k) dst[m][k] = *(const PG8_LAS bf16x8*)(lds + PG8_SA(b, h) + aoff + m * 2048 + k * 1024); } while (0)
#define PG8_LDB(dst, b, h) do { _Pragma("unroll") for (int n = 0; n < 2; ++n) _Pragma("unroll") for (int k = 0; k < 2; ++k) dst[n][k] = *(const PG8_LAS bf16x8*)(lds + PG8_SB(b, h) + boff + n * 2048 + k * 1024); } while (0)
#define PG8_MMA(ai, bj, At, Bt) do { __builtin_amdgcn_s_setprio(1); _Pragma("unroll") for (int m = 0; m < 4; ++m) _Pragma("unroll") for (int n = 0; n < 2; ++n) _Pragma("unroll") for (int k = 0; k < 2; ++k) \
        acc[ai][bj][m][n] = __builtin_amdgcn_mfma_f32_16x16x32_bf16(Bt[n][k], At[m][k], acc[ai][bj][m][n], 0, 0, 0); __builtin_amdgcn_s_setprio(0); } while (0)
#define PG8_WAIT_V(n) asm volatile("s_waitcnt vmcnt(" #n ")" ::: "memory")
#define PG8_WAIT_L(n) asm volatile("s_waitcnt lgkmcnt(" #n ")" ::: "memory")
#define PG8_BAR __builtin_amdgcn_s_barrier()
#define PG8_SCHED __builtin_amdgcn_sched_barrier(0)
    Unit cur, nxt; int ui = 0;
    if (!S.next(0, cur)) return;
    f32x4 acc[2][2][4][2];
#pragma unroll
    for (int a = 0; a < 2; ++a)
#pragma unroll
        for (int b = 0; b < 2; ++b)
#pragma unroll
            for (int m = 0; m < 4; ++m)
#pragma unroll
                for (int n = 0; n < 2; ++n) acc[a][b][m][n] = (f32x4){0.f, 0.f, 0.f, 0.f};
    bf16x8 At[4][2], B0[2][2], B1[2][2];
    const char* cA = (const char*)g.A + (size_t)cur.pm * tstep; const char* cB = (const char*)g.Bt + (size_t)cur.pn * tstep;
    S.a_ready(cur);
    if constexpr (SP2) {
        PG8_STAGE(PG8_SB(0, 0), cB, voffB); PG8_STAGE(PG8_SB(0, 1), cB + hstep, voffB); PG8_STAGE(PG8_SA(0, 0), cA, voffA); PG8_STAGE(PG8_SA(0, 1), cA + hstep, voffA);
        if (wr == 1) PG8_BAR;
        PG8_WAIT_V(2); PG8_BAR;
        PG8_STAGE(PG8_SB(1, 0), cB + kstep, voffB); PG8_STAGE(PG8_SA(1, 0), cA + kstep, voffA); PG8_STAGE(PG8_SB(1, 1), cB + hstep + kstep, voffB);
        PG8_WAIT_V(6); PG8_BAR;
    } else {
        PG8_STAGE(PG8_SB(0, 0), cB, voffB); PG8_STAGE(PG8_SA(0, 0), cA, voffA); PG8_STAGE(PG8_SB(0, 1), cB + hstep, voffB); PG8_STAGE(PG8_SA(0, 1), cA + hstep, voffA);
        if (wr == 1) PG8_BAR;
        PG8_WAIT_V(4); PG8_BAR;
        PG8_STAGE(PG8_SB(1, 0), cB + kstep, voffB); PG8_STAGE(PG8_SA(1, 0), cA + kstep, voffA); PG8_STAGE(PG8_SB(1, 1), cB + hstep + kstep, voffB);
        PG8_WAIT_V(6); PG8_BAR;
    }
    for (;;) {
        const bool has_next = S.next(ui + 1, nxt);
        const char* nA = has_next ? (const char*)g.A + (size_t)nxt.pm * tstep : cA; const char* nB = has_next ? (const char*)g.Bt + (size_t)nxt.pn * tstep : cB;
        for (int t = 0; t < nt; t += 2) {
            const bool last = (t == nt - 2);
            const char* a1 = cA + (size_t)(t + 1) * kstep;
            const char* a2 = last ? nA : cA + (size_t)(t + 2) * kstep; const char* b2 = last ? nB : cB + (size_t)(t + 2) * kstep;
            const char* a3 = a2 + kstep; const char* b3 = b2 + kstep;
            if (last && has_next) S.a_ready(nxt);
            if constexpr (SP2) {
            PG8_LDB(B0, 0, 0); PG8_LDB(B1, 0, 1); PG8_SCHED; PG8_LDA(At, 0, 0); PG8_STAGE(PG8_SA(1, 1), a1 + hstep, voffA);
            PG8_WAIT_V(8); PG8_WAIT_L(0); PG8_BAR; PG8_MMA(0, 0, At, B0); PG8_MMA(0, 1, At, B1); PG8_BAR; PG8_SCHED;
            PG8_LDA(At, 0, 1); PG8_STAGE(PG8_SB(0, 0), b2, voffB); PG8_STAGE(PG8_SB(0, 1), b2 + hstep, voffB); PG8_STAGE(PG8_SA(0, 0), a2, voffA);
            PG8_WAIT_V(8); PG8_WAIT_L(0); PG8_BAR; PG8_MMA(1, 0, At, B0); PG8_MMA(1, 1, At, B1); PG8_BAR; PG8_SCHED;
            PG8_LDB(B0, 1, 0); PG8_LDB(B1, 1, 1); PG8_SCHED; PG8_LDA(At, 1, 0); PG8_STAGE(PG8_SA(0, 1), a2 + hstep, voffA);
            PG8_WAIT_V(8); PG8_WAIT_L(0); PG8_BAR; PG8_MMA(0, 0, At, B0); PG8_MMA(0, 1, At, B1); PG8_BAR; PG8_SCHED;
            PG8_LDA(At, 1, 1); PG8_STAGE(PG8_SB(1, 0), b3, voffB); PG8_STAGE(PG8_SB(1, 1), b3 + hstep, voffB); PG8_STAGE(PG8_SA(1, 0), a3, voffA);
            PG8_WAIT_V(8); PG8_WAIT_L(0); PG8_BAR; PG8_MMA(1, 0, At, B0); PG8_MMA(1, 1, At, B1); PG8_BAR; PG8_SCHED;
            } else {
            PG8_LDB(B0, 0, 0); PG8_SCHED; PG8_LDA(At, 0, 0); PG8_STAGE(PG8_SA(1, 1), a1 + hstep, voffA);
            PG8_WAIT_L(8); PG8_BAR; PG8_WAIT_L(0); PG8_MMA(0, 0, At, B0); PG8_BAR; PG8_SCHED;
            PG8_LDB(B1, 0, 1); PG8_STAGE(PG8_SB(0, 0), b2, voffB);
            PG8_BAR; PG8_WAIT_L(0); PG8_MMA(0, 1, At, B1); PG8_BAR;
            PG8_LDA(At, 0, 1); PG8_STAGE(PG8_SA(0, 0), a2, voffA);
            PG8_BAR; PG8_WAIT_L(0); PG8_MMA(1, 0, At, B0); PG8_BAR; PG8_SCHED;
            PG8_STAGE(PG8_SB(0, 1), b2 + hstep, voffB);
            PG8_WAIT_V(6); PG8_BAR; PG8_MMA(1, 1, At, B1); PG8_BAR;
            PG8_LDB(B0, 1, 0); PG8_SCHED; PG8_LDA(At, 1, 0); PG8_STAGE(PG8_SA(0, 1), a2 + hstep, voffA);
            PG8_WAIT_L(8); PG8_BAR; PG8_WAIT_L(0); PG8_MMA(0, 0, At, B0); PG8_BAR; PG8_SCHED;
            PG8_LDB(B1, 1, 1); PG8_STAGE(PG8_SB(1, 0), b3, voffB);
            PG8_BAR; PG8_WAIT_L(0); PG8_MMA(0, 1, At, B1); PG8_BAR;
            PG8_LDA(At, 1, 1); PG8_STAGE(PG8_SA(1, 0), a3, voffA);
            PG8_BAR; PG8_WAIT_L(0); PG8_MMA(1, 0, At, B0); PG8_BAR; PG8_SCHED;
            PG8_STAGE(PG8_SB(1, 1), b3 + hstep, voffB);
            PG8_WAIT_V(6); PG8_BAR; PG8_MMA(1, 1, At, B1); PG8_BAR;
            }
        }
        if constexpr (ALIGN_EPI) { if (wr == 0) PG8_BAR; }
        if constexpr (!Epi::AFTER_DRAIN) { E(acc, cur, wr, wc, fr, fq); S.done(cur); }
        if (!has_next) break;
#pragma unroll
        for (int a = 0; a < 2; ++a)
#pragma unroll
            for (int b = 0; b < 2; ++b)
#pragma unroll
                for (int m = 0; m < 4; ++m)
#pragma unroll
                    for (int n = 0; n < 2; ++n) acc[a][b][m][n] = (f32x4){0.f, 0.f, 0.f, 0.f};
        cur = nxt; cA = nA; cB = nB; ++ui;
        if constexpr (ALIGN_EPI) { if (wr == 1) PG8_BAR; }
    }
    PG8_WAIT_V(0);
    if constexpr (!ALIGN_EPI) { if (wr == 0) PG8_BAR; }
    PG8_BAR;
    if constexpr (Epi::AFTER_DRAIN) { E.fused(acc, cur, wr, wc, fr, fq, lds, wid, lane); S.done(cur); }
#undef PG8_SA
#undef PG8_SB
#undef PG8_STAGE
#undef PG8_LDA
#undef PG8_LDB
#undef PG8_MMA
#undef PG8_WAIT_V
#undef PG8_WAIT_L
#undef PG8_BAR
#undef PG8_SCHED
}
}

#ifndef PG8_SP2
#define PG8_SP2 true
#endif
#ifndef PG8_ALIGN
#define PG8_ALIGN true
#endif
#define GAS __attribute__((address_space(1)))
#define LAS __attribute__((address_space(3)))
typedef unsigned short bf16;
typedef unsigned v4u __attribute__((ext_vector_type(4)));
typedef float f32x4 __attribute__((ext_vector_type(4)));
typedef short bf16x8 __attribute__((ext_vector_type(8)));
typedef GAS unsigned gu32;
typedef GAS unsigned long long gu64;
#define RLX_AGENT __ATOMIC_RELAXED, __HIP_MEMORY_SCOPE_AGENT
#define LDS_WAIT() asm volatile("s_waitcnt lgkmcnt(0)" ::: "memory")
#define VM_WAIT() asm volatile("s_waitcnt vmcnt(0)" ::: "memory")
__device__ __forceinline__ unsigned long long rt() { return __builtin_amdgcn_s_memrealtime(); }
__device__ __forceinline__ unsigned f2bf(float f) { unsigned u = __builtin_bit_cast(unsigned, f); return (u + 0x7fffu + ((u >> 16) & 1u)) >> 16; }
__device__ __forceinline__ unsigned pk2(float lo, float hi) { return f2bf(lo) | (f2bf(hi) << 16); }

#define XB_TMO      128
#define XB_XCNT(j)  (256  + 64 * (j))
#define XB_XSUB(j)  (1280 + 64 * (j))
#define XB_XGEN(j)  (2304 + 64 * (j))
#define XB_TOP      3328
#define XB_TOPGEN   3392
#define XCD_BAR_WORDS 3456
#define XB_SPIN_CAP (1u << 18)

__device__ __forceinline__ unsigned xb_ld(unsigned* p)              { return __hip_atomic_load(p, __ATOMIC_RELAXED, __HIP_MEMORY_SCOPE_AGENT); }
__device__ __forceinline__ unsigned xb_add(unsigned* p, unsigned v) { return __hip_atomic_fetch_add(p, v, __ATOMIC_RELAXED, __HIP_MEMORY_SCOPE_AGENT); }
__device__ __forceinline__ unsigned xb_xcc_id() { return (unsigned)__builtin_amdgcn_s_getreg((3 << 11) | 20) & 0xFu; }
#define XB_SPIN(cond, bar) do { unsigned _sp = 0; while (cond) { __builtin_amdgcn_s_sleep(1); \
    if ((++_sp & 255u) == 0u) { if (xb_ld(&(bar)[XB_TMO])) break; if (_sp > XB_SPIN_CAP) { atomicAdd(&(bar)[XB_TMO], 1u); break; } } } } while (0)

struct XcdBarrier {
    unsigned* bar; unsigned x;
    volatile LAS unsigned* st;
};

__device__ __forceinline__ XcdBarrier xcd_barrier_post(unsigned* bar, volatile LAS unsigned* st) {
    XcdBarrier b; b.bar = bar; b.x = xb_xcc_id(); b.st = st;
    if (threadIdx.x == 0) (void)xb_add(&bar[XB_XCNT(b.x)], 1u);
    return b;
}
__device__ __forceinline__ void xcd_barrier_complete(unsigned* bar, unsigned x, unsigned& nloc, unsigned& nx) {
    const unsigned G = gridDim.x * gridDim.y * gridDim.z;
    unsigned sum, cnt, mine, sp = 0u;
    for (;;) {
        sum = 0u; cnt = 0u; mine = 0u;
#pragma unroll
        for (unsigned j = 0; j < 16; ++j) { const unsigned c = xb_ld(&bar[XB_XCNT(j)]); sum += c; cnt += (c > 0u) ? 1u : 0u; mine = (j == x) ? c : mine; }
        if (sum == G) break;
        __builtin_amdgcn_s_sleep(1);
        if ((++sp & 255u) == 0u) { if (xb_ld(&bar[XB_TMO])) break; if (sp > XB_SPIN_CAP) { atomicAdd(&bar[XB_TMO], 1u); break; } }
    }
    nloc = mine > 0u ? mine : 1u; nx = cnt > 0u ? cnt : 1u;
}

__device__ __forceinline__ void xcd_barrier(const XcdBarrier& b) {
    asm volatile("s_waitcnt vmcnt(0)" ::: "memory");
    __syncthreads();
    if (threadIdx.x == 0) {
        unsigned* bar = b.bar;
        __builtin_amdgcn_s_waitcnt(0);
        unsigned nloc = b.st[0], nx = b.st[1];
        if (nloc == 0u) { xcd_barrier_complete(bar, b.x, nloc, nx); b.st[0] = nloc; b.st[1] = nx; }
        const unsigned old = xb_add(&bar[XB_XSUB(b.x)], 1u);
        const unsigned gen = old / nloc;
        if (old + 1u == (gen + 1u) * nloc) {
            __builtin_amdgcn_fence(__ATOMIC_RELEASE, "agent");
            asm volatile("s_waitcnt vmcnt(0)" ::: "memory");
            const unsigned og = xb_add(&bar[XB_TOP], 1u);
            const unsigned tg = og / nx;
            if (og + 1u == (tg + 1u) * nx) xb_add(&bar[XB_TOPGEN], 1u);
            else XB_SPIN(xb_ld(&bar[XB_TOPGEN]) == tg, bar);
            __builtin_amdgcn_fence(__ATOMIC_ACQUIRE, "agent");
            xb_add(&bar[XB_XGEN(b.x)], 1u);
            asm volatile("s_waitcnt vmcnt(0)" ::: "memory");
        } else {
            XB_SPIN(xb_ld(&bar[XB_XGEN(b.x)]) == gen, bar);
            __builtin_amdgcn_fence(__ATOMIC_ACQUIRE, "agent");
            asm volatile("s_waitcnt vmcnt(0)" ::: "memory");
        }
    }
    __syncthreads();
}

constexpr int NWAVES = 8;
constexpr int D_MODEL = 1024, BATCH = 4, SEQ = 4096, M = BATCH * SEQ;
constexpr int N_HEADS = 8, GQA = 4, WINDOW = 128;
constexpr int D_ATTN = 512, D_CONV = 512, CONVW = 31;
constexpr int D_IN = 2816;
constexpr int C_Q = 0, C_K = 512, C_V = 640, C_ZA = 768, C_A = 1280, C_G = 1792, C_ZC = 2304;
constexpr float EPS = 1e-6f, LN_EPS = 1e-5f;
constexpr float LOG2E = 1.4426950408889634f;
constexpr float NEG_BIG = -1e30f;

constexpr size_t MiB = 1u << 20;
constexpr size_t WS_CTL = 0, CTL_ZERO_BYTES = 64 * 1024;
constexpr size_t WS_WIN = 2 * MiB;
constexpr size_t WS_WOUT = 8 * MiB;
constexpr size_t WS_XN = 16 * MiB;
constexpr size_t WS_P = 48 * MiB;
constexpr size_t WS_Y = 136 * MiB;
constexpr size_t WS_YC = 168 * MiB;
constexpr size_t WS_END = 200 * MiB;
constexpr int CW_BAR = 1024;
static_assert((CW_BAR + XCD_BAR_WORDS) * 4 <= (int)CTL_ZERO_BYTES, "control words inside the memset region");

constexpr int RING_BYTES = 131072;
constexpr int MISC_OFF = RING_BYTES + 320;
constexpr int LDS_BYTES = 147456;

typedef float f32x16 __attribute__((ext_vector_type(16)));
typedef float f32x2 __attribute__((ext_vector_type(2)));
typedef short s16x4 __attribute__((ext_vector_type(4)));
typedef short v4i16_t __attribute__((ext_vector_type(4)));
typedef unsigned u32x2 __attribute__((ext_vector_type(2)));

__device__ __forceinline__ float bf_lo(unsigned w) { return __builtin_bit_cast(float, w << 16); }
__device__ __forceinline__ float bf_hi(unsigned w) { return __builtin_bit_cast(float, w & 0xffff0000u); }
__device__ __forceinline__ float silu_f(float z) { return z * __builtin_amdgcn_rcpf(1.0f + __builtin_amdgcn_exp2f(-LOG2E * z)); }
__device__ __forceinline__ float sigmoid_f(float z) { return __builtin_amdgcn_rcpf(1.0f + __builtin_amdgcn_exp2f(-LOG2E * z)); }
__device__ __forceinline__ float wave_sum(float v) {
#pragma unroll
    for (int o = 1; o < 64; o <<= 1) v += __shfl_xor(v, o);
    return v;
}
__device__ __forceinline__ float hsum32(float v) {
    auto rr = __builtin_amdgcn_permlane32_swap(__float_as_uint(v), __float_as_uint(v), false, false);
    return __uint_as_float(rr[0]) + __uint_as_float(rr[1]);
}
__device__ __forceinline__ float hmax32(float v) {
    auto rr = __builtin_amdgcn_permlane32_swap(__float_as_uint(v), __float_as_uint(v), false, false);
    return fmaxf(__uint_as_float(rr[0]), __uint_as_float(rr[1]));
}
__device__ __forceinline__ int t5_bucket(int dist) {
    if (dist < 16) return dist;
    const float nf = (float)dist;
    int large = 16 + (int)(logf(nf / 16.0f) / 2.0794415416798357f * 16.0f);
    return large < 31 ? large : 31;
}

__device__ __forceinline__ void p0_transpose_item(const float* W, int K, int N, bf16* WT, LAS float* scr, int item, int lane) {
    const int nblk = N / 32, kb = item / nblk, nb = item % nblk, k0 = 64 * kb, n0 = 32 * nb;
#pragma unroll 8
    for (int i = 0; i < 32; ++i) { const int kk = 2 * i + (lane >> 5); scr[kk * 33 + (lane & 31)] = W[(size_t)(k0 + kk) * N + n0 + (lane & 31)]; }
    LDS_WAIT(); asm volatile("" ::: "memory");
    const int c = lane & 7;
#pragma unroll
    for (int j = 0; j < 4; ++j) { const int n = (lane >> 3) + 8 * j; const LAS float* s = scr + (8 * c) * 33 + n;
        v4u o; o.x = pk2(s[0 * 33], s[1 * 33]); o.y = pk2(s[2 * 33], s[3 * 33]); o.z = pk2(s[4 * 33], s[5 * 33]); o.w = pk2(s[6 * 33], s[7 * 33]);
        *(GAS v4u*)(WT + (size_t)(n0 + n) * K + k0 + 8 * c) = o; }
    LDS_WAIT(); asm volatile("" ::: "memory");
}
__device__ __forceinline__ void p0_prologue(LAS unsigned char* lds, int gw, int NGW, int wave, int lane, const float* x, const float* norm_w, const float* w_in, const float* w_out, bf16* WIN, bf16* WOUT, bf16* XN) {
    LAS float* scr = (LAS float*)(lds + wave * 16384);
    constexpr int I_IN = (D_MODEL / 64) * (D_IN / 32), I_OUT = (D_MODEL / 64) * (D_MODEL / 32);
    for (int it = gw; it < I_IN + I_OUT; it += NGW) {
        if (it < I_IN) p0_transpose_item(w_in, D_MODEL, D_IN, WIN, scr, it, lane);
        else p0_transpose_item(w_out, D_MODEL, D_MODEL, WOUT, scr, it - I_IN, lane);
    }
    f32x4 nw[4];
#pragma unroll
    for (int j = 0; j < 4; ++j) nw[j] = *((const GAS f32x4*)norm_w + lane + 64 * j);
    for (int m = gw; m < M; m += NGW) {
        const GAS f32x4* xr = (const GAS f32x4*)(x + (size_t)m * D_MODEL) + lane;
        f32x4 v[4]; float s = 0.f;
#pragma unroll
        for (int j = 0; j < 4; ++j) { v[j] = xr[64 * j]; s += (v[j].x * v[j].x + v[j].y * v[j].y) + (v[j].z * v[j].z + v[j].w * v[j].w); }
        const float rs = 1.0f / sqrtf(wave_sum(s) * (1.0f / D_MODEL) + EPS);
        GAS unsigned long long* o8 = (GAS unsigned long long*)(XN + (size_t)m * D_MODEL) + lane;
#pragma unroll
        for (int j = 0; j < 4; ++j) { const f32x4 y = v[j] * rs * nw[j]; o8[64 * j] = (unsigned long long)pk2(y.x, y.y) | ((unsigned long long)pk2(y.z, y.w) << 32); }
    }
}

constexpr int AT_K = 0, AT_V = 32768, AT_VPLANE = 16384, AT_TAB = 65536, AT_OST = 65536 + 4096, AT_OROW = 144, AT_OST_WAVE = 32 * AT_OROW, AT_END = AT_OST + 8 * AT_OST_WAVE;
static_assert(AT_END <= RING_BYTES, "attention LDS");
__device__ __forceinline__ int crow(int r, int hi) { return (r & 3) + 8 * (r >> 2) + 4 * hi; }
__device__ __forceinline__ s16x4 vtr(const LAS unsigned char* p) { return __builtin_bit_cast(s16x4, __builtin_amdgcn_ds_read_tr16_b64_v4i16((LAS v4i16_t*)p)); }

__device__ __forceinline__ void attn_unit(LAS unsigned char* lds, int unit, int tid, int lane, int wid, const bf16* P, bf16* Y,
                                          const float* qnw, const float* knw, const float* sinks, const float* relb) {
    const int kvh = unit & 1, nb = (unit >> 1) & 31, b = unit >> 6;
    const int row0 = b * SEQ + nb * 128;
#pragma unroll
    for (int i = 0; i < 4; ++i) {
        const int idx = tid + 512 * i, s = idx >> 3, ch = idx & 7;
        const bool valid = (nb > 0) || (s >= 128);
        v4u kraw = (v4u){0u, 0u, 0u, 0u}, vraw = (v4u){0u, 0u, 0u, 0u};
        if (valid) { const bf16* pr = P + (size_t)(row0 - 128 + s) * D_IN + kvh * 64 + ch * 8; kraw = *(const GAS v4u*)(pr + C_K); vraw = *(const GAS v4u*)(pr + C_V); }
        float kf[8];
#pragma unroll
        for (int j = 0; j < 4; ++j) { kf[2 * j] = bf_lo(kraw[j]); kf[2 * j + 1] = bf_hi(kraw[j]); }
        float ss = 0.f;
#pragma unroll
        for (int j = 0; j < 8; ++j) ss += kf[j] * kf[j];
        ss += __shfl_xor(ss, 1); ss += __shfl_xor(ss, 2); ss += __shfl_xor(ss, 4);
        const float rs = 1.0f / sqrtf(ss * (1.0f / 64.0f) + EPS);
        const f32x4 w0 = *(const GAS f32x4*)(knw + ch * 8), w1 = *(const GAS f32x4*)(knw + ch * 8 + 4);
        v4u kn; kn.x = pk2(kf[0] * rs * w0.x, kf[1] * rs * w0.y); kn.y = pk2(kf[2] * rs * w0.z, kf[3] * rs * w0.w);
        kn.z = pk2(kf[4] * rs * w1.x, kf[5] * rs * w1.y); kn.w = pk2(kf[6] * rs * w1.z, kf[7] * rs * w1.w);
        *(LAS v4u*)(lds + AT_K + s * 128 + ((ch ^ ((s >> 1) & 7)) << 4)) = kn;
        *(LAS v4u*)(lds + AT_V + (ch >> 2) * AT_VPLANE + s * 64 + (ch & 3) * 16) = vraw;
    }
    for (int i = tid; i < 4 * 192; i += 512) {
        const int g = i / 192, dist = (i % 192) - 32;
        float v = NEG_BIG;
        if (dist >= 0 && dist < WINDOW) v = relb[t5_bucket(dist) * N_HEADS + kvh * 4 + g] * LOG2E;
        ((LAS float*)(lds + AT_TAB))[i] = v;
    }
    __syncthreads();
    const int g = wid >> 1, h = kvh * 4 + g, r32 = lane & 31, hi = lane >> 5;
    const float sink2 = sinks[h] * LOG2E;
    const LAS float* tab = (const LAS float*)(lds + AT_TAB) + g * 192;
    LAS unsigned char* stg = lds + AT_OST + wid * AT_OST_WAVE;
    const int vlane = ((lane >> 4) & 1) * 32 + (lane & 3) * 8 + (4 * hi + ((lane & 15) >> 2)) * 64;
#pragma unroll 1
    for (int qq = 0; qq < 2; ++qq) {
        const int a = (wid & 1) * 2 + qq;
        const bf16* qp = P + (size_t)(row0 + 32 * a + r32) * D_IN + C_Q + h * 64 + hi * 8;
        v4u qraw[4];
#pragma unroll
        for (int d0 = 0; d0 < 4; ++d0) qraw[d0] = *(const GAS v4u*)(qp + d0 * 16);
        float ss = 0.f;
#pragma unroll
        for (int d0 = 0; d0 < 4; ++d0)
#pragma unroll
            for (int j = 0; j < 4; ++j) { const float lo = bf_lo(qraw[d0][j]), hv = bf_hi(qraw[d0][j]); ss += lo * lo + hv * hv; }
        ss = hsum32(ss);
        const float qs = (1.0f / sqrtf(ss * (1.0f / 64.0f) + EPS)) * (0.125f * LOG2E);
        bf16x8 qr[4];
#pragma unroll
        for (int d0 = 0; d0 < 4; ++d0) {
            const f32x4 w0 = *(const GAS f32x4*)(qnw + d0 * 16 + hi * 8), w1 = *(const GAS f32x4*)(qnw + d0 * 16 + hi * 8 + 4);
            v4u t; t.x = pk2(bf_lo(qraw[d0].x) * qs * w0.x, bf_hi(qraw[d0].x) * qs * w0.y); t.y = pk2(bf_lo(qraw[d0].y) * qs * w0.z, bf_hi(qraw[d0].y) * qs * w0.w);
            t.z = pk2(bf_lo(qraw[d0].z) * qs * w1.x, bf_hi(qraw[d0].z) * qs * w1.y); t.w = pk2(bf_lo(qraw[d0].w) * qs * w1.z, bf_hi(qraw[d0].w) * qs * w1.w);
            qr[d0] = __builtin_bit_cast(bf16x8, t);
        }
        f32x16 S[5];
#pragma unroll
        for (int t = 0; t < 5; ++t) {
            const int st = a + t;
            const bool dead = (nb == 0) && (st < 4);
#pragma unroll
            for (int r = 0; r < 16; ++r) { const float tv = tab[r32 + 160 - 32 * t - crow(r, hi)]; S[t][r] = dead ? NEG_BIG : tv; }
            const int key = 32 * st + r32;
            const LAS unsigned char* kp = lds + AT_K + key * 128;
            const int sw = (key >> 1) & 7;
#pragma unroll
            for (int d0 = 0; d0 < 4; ++d0) {
                const bf16x8 kf = *(const LAS bf16x8*)(kp + (((2 * d0 + hi) ^ sw) << 4));
                S[t] = __builtin_amdgcn_mfma_f32_32x32x16_bf16(kf, qr[d0], S[t], 0, 0, 0);
            }
        }
        float mx = sink2;
#pragma unroll
        for (int t = 0; t < 5; ++t)
#pragma unroll
            for (int r = 0; r < 16; ++r) mx = fmaxf(mx, S[t][r]);
        mx = hmax32(mx);
        float l = 0.f;
#pragma unroll
        for (int t = 0; t < 5; ++t)
#pragma unroll
            for (int r = 0; r < 16; ++r) { S[t][r] = __builtin_amdgcn_exp2f(S[t][r] - mx); l += S[t][r]; }
        l = hsum32(l);
        l += __builtin_amdgcn_exp2f(sink2 - mx);
        const float rl = 1.0f / l;
        f32x16 O[2];
#pragma unroll
        for (int d0 = 0; d0 < 2; ++d0)
#pragma unroll
            for (int r = 0; r < 16; ++r) O[d0][r] = 0.f;
#pragma unroll
        for (int t = 0; t < 5; ++t) {
            const int st = a + t;
#pragma unroll
            for (int s = 0; s < 2; ++s) {
                v4u pw;
#pragma unroll
                for (int j = 0; j < 4; ++j) pw[j] = pk2(S[t][8 * s + 2 * j], S[t][8 * s + 2 * j + 1]);
                const bf16x8 pf = __builtin_bit_cast(bf16x8, pw);
#pragma unroll
                for (int d0 = 0; d0 < 2; ++d0) {
                    const LAS unsigned char* vp = lds + AT_V + d0 * AT_VPLANE + (32 * st + 16 * s) * 64 + vlane;
                    const s16x4 lo = vtr(vp), hv = vtr(vp + 8 * 64);
                    const bf16x8 vf = (bf16x8){lo[0], lo[1], lo[2], lo[3], hv[0], hv[1], hv[2], hv[3]};
                    O[d0] = __builtin_amdgcn_mfma_f32_32x32x16_bf16(vf, pf, O[d0], 0, 0, 0);
                }
            }
        }
#pragma unroll
        for (int d0 = 0; d0 < 2; ++d0)
#pragma unroll
            for (int gq = 0; gq < 4; ++gq) {
                u32x2 w; w.x = pk2(O[d0][4 * gq] * rl, O[d0][4 * gq + 1] * rl); w.y = pk2(O[d0][4 * gq + 2] * rl, O[d0][4 * gq + 3] * rl);
                *(LAS u32x2*)(stg + r32 * AT_OROW + (32 * d0 + 8 * gq + 4 * hi) * 2) = w;
            }
        LDS_WAIT(); asm volatile("" ::: "memory");
#pragma unroll
        for (int i = 0; i < 4; ++i) {
            const int row = 8 * i + (lane >> 3), c = lane & 7;
            const v4u ov = *(const LAS v4u*)(stg + row * AT_OROW + c * 16);
            const size_t tok = (size_t)(row0 + 32 * a + row);
            const v4u zv = *(const GAS v4u*)(P + tok * D_IN + C_ZA + h * 64 + c * 8);
            v4u yv;
#pragma unroll
            for (int j = 0; j < 4; ++j) yv[j] = pk2(bf_lo(ov[j]) * silu_f(bf_lo(zv[j])), bf_hi(ov[j]) * silu_f(bf_hi(zv[j])));
            *(GAS v4u*)(Y + tok * D_MODEL + h * 64 + c * 8) = yv;
        }
        LDS_WAIT(); asm volatile("" ::: "memory");
    }
}

constexpr int CV_PF = 12;
__device__ __forceinline__ void conv_unit(LAS unsigned char* lds, int unit, int tid, int lane, int wid, const bf16* P, bf16* Y,
                                          const float* dww, const float* dwb, const float* lnw, const float* lnb) {
    const int r0 = unit * 64, t0 = r0 % SEQ;
    LAS float* YB = (LAS float*)lds;
    {
        int cp = tid & 255; asm volatile("" : "+v"(cp));
        const int th = tid >> 8, c0 = 2 * cp;
        f32x2 w[CONVW], acc[CONVW];
#pragma unroll
        for (int j = 0; j < CONVW; ++j) { w[j] = *(const GAS f32x2*)(dww + j * D_CONV + c0); acc[j] = (f32x2){0.f, 0.f}; }
        const f32x2 bias = *(const GAS f32x2*)(dwb + c0);
        const int tb = 32 * th - 30;
        unsigned ra[CONVW], rg[CONVW];
#pragma unroll
        for (int s = 0; s < CV_PF; ++s) {
            const int trel = tb + s; const bool ok = (t0 + trel) >= 0; const bf16* pr = P + (size_t)(r0 + (ok ? trel : 0)) * D_IN + c0;
            ra[s] = *(const GAS unsigned*)(pr + C_A); rg[s] = *(const GAS unsigned*)(pr + C_G);
        }
#pragma unroll 1
        for (int ob = 0; ob < 2; ++ob) {
#pragma unroll
            for (int s = 0; s < CONVW; ++s) {
                const int step = ob * CONVW + s, trel = tb + step;
                {
                    int pstep = step + CV_PF; if (pstep > 2 * CONVW - 1) pstep = 2 * CONVW - 1;
                    const int ptrel = tb + pstep; const bool pok = (t0 + ptrel) >= 0; const bf16* pr = P + (size_t)(r0 + (pok ? ptrel : 0)) * D_IN + c0;
                    ra[(s + CV_PF) % CONVW] = *(const GAS unsigned*)(pr + C_A); rg[(s + CV_PF) % CONVW] = *(const GAS unsigned*)(pr + C_G);
                }
                const bool ok = (t0 + trel) >= 0;
                f32x2 u;
                u.x = bf_lo(ra[s]) * sigmoid_f(bf_lo(rg[s])); u.y = bf_hi(ra[s]) * sigmoid_f(bf_hi(rg[s]));
                if (!ok) u = (f32x2){0.f, 0.f};
#pragma unroll
                for (int i = 0; i < CONVW; ++i) acc[(i + s) % CONVW] += u * w[CONVW - 1 - i];
                if (step >= CONVW - 1) *(LAS f32x2*)(YB + (trel) * D_CONV + c0) = acc[s] + bias;
                acc[s] = (f32x2){0.f, 0.f};
                asm volatile("" ::: "memory");
            }
        }
    }
    __syncthreads();
    {
        int l4 = 4 * lane; asm volatile("" : "+v"(l4));
        const f32x4 lw0 = *(const GAS f32x4*)(lnw + l4), lw1 = *(const GAS f32x4*)(lnw + 256 + l4);
        const f32x4 lb0 = *(const GAS f32x4*)(lnb + l4), lb1 = *(const GAS f32x4*)(lnb + 256 + l4);
#pragma unroll 2
        for (int i = 0; i < 8; ++i) {
            const int tok = wid * 8 + i;
            const f32x4 v0 = *(const LAS f32x4*)(YB + tok * D_CONV + 4 * lane), v1 = *(const LAS f32x4*)(YB + tok * D_CONV + 256 + 4 * lane);
            const bf16* zp = P + (size_t)(r0 + tok) * D_IN + C_ZC + 4 * lane;
            const u32x2 z0 = *(const GAS u32x2*)zp, z1 = *(const GAS u32x2*)(zp + 256);
            const float mu = wave_sum((v0.x + v0.y) + (v0.z + v0.w) + (v1.x + v1.y) + (v1.z + v1.w)) * (1.0f / D_CONV);
            const f32x4 d0 = v0 - mu, d1 = v1 - mu;
            const float var = wave_sum((d0.x * d0.x + d0.y * d0.y) + (d0.z * d0.z + d0.w * d0.w) + (d1.x * d1.x + d1.y * d1.y) + (d1.z * d1.z + d1.w * d1.w)) * (1.0f / D_CONV);
            const float rstd = 1.0f / sqrtf(var + LN_EPS);
            const f32x4 y0 = d0 * rstd * lw0 + lb0, y1 = d1 * rstd * lw1 + lb1;
            u32x2 o0, o1;
            o0.x = pk2(silu_f(y0.x) * silu_f(bf_lo(z0.x)), silu_f(y0.y) * silu_f(bf_hi(z0.x))); o0.y = pk2(silu_f(y0.z) * silu_f(bf_lo(z0.y)), silu_f(y0.w) * silu_f(bf_hi(z0.y)));
            o1.x = pk2(silu_f(y1.x) * silu_f(bf_lo(z1.x)), silu_f(y1.y) * silu_f(bf_hi(z1.x))); o1.y = pk2(silu_f(y1.z) * silu_f(bf_lo(z1.y)), silu_f(y1.w) * silu_f(bf_hi(z1.y)));
            bf16* yp = Y + (size_t)(r0 + tok) * D_MODEL + D_ATTN + 4 * lane;
            *(GAS u32x2*)yp = o0; *(GAS u32x2*)(yp + 256) = o1;
        }
    }
}

struct Args { const float* in[12]; float* out; unsigned char* ws; int ph_lo, ph_hi, p2mask, pad; };
__global__ void __launch_bounds__(NWAVES * 64, 2) hymba_fwd(Args args) {
    extern __shared__ __attribute__((aligned(16))) unsigned char lds_raw[];
    LAS unsigned char* lds = (LAS unsigned char*)lds_raw;
    volatile LAS unsigned* MISC = (volatile LAS unsigned*)(lds + MISC_OFF);
    const int tid = threadIdx.x, lane = tid & 63, wave = __builtin_amdgcn_readfirstlane(tid >> 6);
    const int G = gridDim.x; const int bx = blockIdx.x;
    const int vcu = (G % 8 == 0) ? (bx % 8) * (G / 8) + bx / 8 : bx;
    unsigned char* ws = args.ws;
    gu32* ctl = (gu32*)(ws + WS_CTL);
    const float* x = args.in[0]; const float* norm_w = args.in[1]; const float* w_in = args.in[2]; const float* qnw = args.in[3]; const float* knw = args.in[4];
    const float* sinks = args.in[5]; const float* dww = args.in[6]; const float* dwb = args.in[7]; const float* lnw = args.in[8]; const float* lnb = args.in[9];
    const float* w_out = args.in[10]; const float* relb = args.in[11];
    bf16* WIN = (bf16*)(ws + WS_WIN); bf16* WOUT = (bf16*)(ws + WS_WOUT); bf16* XN = (bf16*)(ws + WS_XN); bf16* P = (bf16*)(ws + WS_P); bf16* Y = (bf16*)(ws + WS_Y);
    for (int u = tid; u < (LDS_BYTES - RING_BYTES) / 4; u += NWAVES * 64) ((LAS unsigned*)(lds + RING_BYTES))[u] = 0u;
    __syncthreads();
    const int lo = args.ph_lo, hi = args.ph_hi;
    const bool use_bar = (hi - lo) > 1;
    XcdBarrier bar; bar.bar = (unsigned*)(ctl + CW_BAR); bar.x = 0; bar.st = nullptr;
    if (use_bar) bar = xcd_barrier_post((unsigned*)(ctl + CW_BAR), MISC + 8);
#define IN(k) (lo <= (k) && (k) < hi)
#define BOTH(k) (IN(k) && IN((k) + 1))
    if (IN(0)) {
        p0_prologue(lds, vcu * NWAVES + wave, G * NWAVES, wave, lane, x, norm_w, w_in, w_out, WIN, WOUT, XN);
        if (BOTH(0)) xcd_barrier(bar);
    }
    if (IN(1)) {
        pg8::Gemm g{XN, WIN, M, D_IN, D_MODEL}; pg8::StaticOrder S; S.init(M, D_IN, G, bx);
        pg8::EpiBf16<0> E{P, D_IN, nullptr, 0, 0, 1.f};
        pg8::gemm_phase<pg8::EpiBf16<0>, pg8::StaticOrder, PG8_ALIGN, PG8_SP2>(lds, g, S, E);
        if (BOTH(1)) xcd_barrier(bar);
    }
    if (IN(2)) {
        for (int u = vcu; u < 256; u += G) {
            if (args.p2mask & 1) { int t_ = tid; asm volatile("" : "+v"(t_)); attn_unit(lds, u, t_, t_ & 63, wave, P, Y, qnw, knw, sinks, relb); __syncthreads(); }
            if (args.p2mask & 2) { int t_ = tid; asm volatile("" : "+v"(t_)); conv_unit(lds, u, t_, t_ & 63, wave, P, Y, dww, dwb, lnw, lnb); __syncthreads(); }
        }
        if (BOTH(2)) xcd_barrier(bar);
    }
    if (IN(3)) {
        pg8::Gemm g{Y, WOUT, M, D_MODEL, D_MODEL}; pg8::StaticOrder S; S.init(M, D_MODEL, G, bx);
        pg8::EpiResF32 E{args.out, x, D_MODEL};
        pg8::gemm_phase<pg8::EpiResF32, pg8::StaticOrder, PG8_ALIGN, PG8_SP2>(lds, g, S, E);
    }
#undef IN
#undef BOTH
}

__device__ __forceinline__ float bf2f(bf16 b) { return __builtin_bit_cast(float, (unsigned)b << 16); }
__device__ __forceinline__ float silu_n(float z) { return z / (1.0f + __expf(-z)); }
__global__ void nv_transpose(const float* __restrict__ W, int K, int N, bf16* __restrict__ WT) {
    const int idx = blockIdx.x * blockDim.x + threadIdx.x;
    if (idx >= K * N) return;
    const int n = idx / K, k = idx % K;
    WT[(size_t)n * K + k] = (bf16)f2bf(W[(size_t)k * N + n]);
}
__global__ void nv_rmsnorm(const float* __restrict__ x, const float* __restrict__ w, bf16* __restrict__ xn) {
    const int row = blockIdx.x * (blockDim.x / 64) + (threadIdx.x >> 6), lane = threadIdx.x & 63;
    if (row >= M) return;
    const float* xr = x + (size_t)row * D_MODEL;
    float s = 0.f;
    for (int c = lane; c < D_MODEL; c += 64) s += xr[c] * xr[c];
    for (int o = 1; o < 64; o <<= 1) s += __shfl_xor(s, o);
    const float rs = 1.0f / sqrtf(s * (1.0f / D_MODEL) + EPS);
    for (int c = lane; c < D_MODEL; c += 64) xn[(size_t)row * D_MODEL + c] = (bf16)f2bf(xr[c] * rs * w[c]);
}
template <int MODE>
__global__ void nv_gemm(const bf16* __restrict__ A, const bf16* __restrict__ Bt, int Mr, int N, int K, bf16* __restrict__ Cb, float* __restrict__ Cf, const float* __restrict__ res) {
    __shared__ float As[16][65], Bs[16][65];
    const int tx = threadIdx.x & 15, ty = threadIdx.x >> 4;
    const int m0 = blockIdx.y * 64, n0 = blockIdx.x * 64;
    float acc[4][4] = {};
    for (int k0 = 0; k0 < K; k0 += 16) {
        for (int i = threadIdx.x; i < 64 * 16; i += 256) { const int r = i >> 4, c = i & 15; As[c][r] = bf2f(A[(size_t)(m0 + r) * K + k0 + c]); Bs[c][r] = bf2f(Bt[(size_t)(n0 + r) * K + k0 + c]); }
        __syncthreads();
#pragma unroll
        for (int kk = 0; kk < 16; ++kk) {
            float a[4], b[4];
#pragma unroll
            for (int i = 0; i < 4; ++i) { a[i] = As[kk][ty * 4 + i]; b[i] = Bs[kk][tx * 4 + i]; }
#pragma unroll
            for (int i = 0; i < 4; ++i)
#pragma unroll
                for (int j = 0; j < 4; ++j) acc[i][j] += a[i] * b[j];
        }
        __syncthreads();
    }
#pragma unroll
    for (int i = 0; i < 4; ++i)
#pragma unroll
        for (int j = 0; j < 4; ++j) {
            const size_t o = (size_t)(m0 + ty * 4 + i) * N + n0 + tx * 4 + j;
            if (MODE == 0) Cb[o] = (bf16)f2bf(acc[i][j]); else Cf[o] = res[o] + acc[i][j];
        }
}
__global__ void __launch_bounds__(256) nv_attn(const bf16* __restrict__ P, const float* __restrict__ qnw, const float* __restrict__ knw, const float* __restrict__ sinks, const float* __restrict__ relb, bf16* __restrict__ Y) {
    const int idx = blockIdx.x * blockDim.x + threadIdx.x;
    if (idx >= M * N_HEADS) return;
    const int h = idx % N_HEADS, row = idx / N_HEADS, t = row % SEQ, kvh = h / GQA;
    const bf16* pr = P + (size_t)row * D_IN;
    float q[64]; float ss = 0.f;
#pragma unroll
    for (int d = 0; d < 64; ++d) { q[d] = bf2f(pr[C_Q + h * 64 + d]); ss += q[d] * q[d]; }
    const float rs = 1.0f / sqrtf(ss / 64.0f + EPS);
#pragma unroll
    for (int d = 0; d < 64; ++d) q[d] = q[d] * rs * qnw[d];
    float m = sinks[h], l = 1.0f; float o[64];
#pragma unroll
    for (int d = 0; d < 64; ++d) o[d] = 0.f;
    const int klo = t - (WINDOW - 1) < 0 ? 0 : t - (WINDOW - 1);
    for (int kp = klo; kp <= t; ++kp) {
        const bf16* kr = P + (size_t)(row - t + kp) * D_IN;
        float ks = 0.f, dot = 0.f;
#pragma unroll
        for (int d = 0; d < 64; ++d) { const float kv = bf2f(kr[C_K + kvh * 64 + d]); ks += kv * kv; dot += q[d] * kv * knw[d]; }
        const float krs = 1.0f / sqrtf(ks / 64.0f + EPS);
        const float logit = dot * krs * 0.125f + relb[t5_bucket(t - kp) * N_HEADS + h];
        const float mn = fmaxf(m, logit), f = __expf(m - mn), p = __expf(logit - mn);
        l = l * f + p;
#pragma unroll
        for (int d = 0; d < 64; ++d) o[d] = o[d] * f + p * bf2f(kr[C_V + kvh * 64 + d]);
        m = mn;
    }
#pragma unroll
    for (int d = 0; d < 64; ++d) {
        const float z = bf2f(pr[C_ZA + h * 64 + d]);
        Y[(size_t)row * D_MODEL + h * 64 + d] = (bf16)f2bf(o[d] / l * silu_n(z));
    }
}
__global__ void nv_conv(const bf16* __restrict__ P, const float* __restrict__ dww, const float* __restrict__ dwb, float* __restrict__ yc) {
    const int idx = blockIdx.x * blockDim.x + threadIdx.x;
    if (idx >= M * D_CONV) return;
    const int c = idx % D_CONV, row = idx / D_CONV, t = row % SEQ;
    float acc = dwb[c];
    for (int j = 0; j < CONVW; ++j) {
        const int tt = t - (CONVW - 1) + j;
        if (tt < 0) continue;
        const bf16* pr = P + (size_t)(row - t + tt) * D_IN;
        const float a = bf2f(pr[C_A + c]), g = bf2f(pr[C_G + c]);
        acc += a / (1.0f + __expf(-g)) * dww[j * D_CONV + c];
    }
    yc[(size_t)row * D_CONV + c] = acc;
}
__global__ void nv_ln(const float* __restrict__ yc, const bf16* __restrict__ P, const float* __restrict__ lnw, const float* __restrict__ lnb, bf16* __restrict__ Y) {
    const int row = blockIdx.x * (blockDim.x / 64) + (threadIdx.x >> 6), lane = threadIdx.x & 63;
    if (row >= M) return;
    const float* yr = yc + (size_t)row * D_CONV;
    float v[8]; float s = 0.f;
#pragma unroll
    for (int i = 0; i < 8; ++i) { v[i] = yr[lane + 64 * i]; s += v[i]; }
    for (int o = 1; o < 64; o <<= 1) s += __shfl_xor(s, o);
    const float mu = s / D_CONV; float q = 0.f;
#pragma unroll
    for (int i = 0; i < 8; ++i) { const float d = v[i] - mu; q += d * d; }
    for (int o = 1; o < 64; o <<= 1) q += __shfl_xor(q, o);
    const float rstd = 1.0f / sqrtf(q / D_CONV + LN_EPS);
#pragma unroll
    for (int i = 0; i < 8; ++i) {
        const int c = lane + 64 * i;
        const float yv = (v[i] - mu) * rstd * lnw[c] + lnb[c];
        const float z = bf2f(P[(size_t)row * D_IN + C_ZC + c]);
        Y[(size_t)row * D_MODEL + D_ATTN + c] = (bf16)f2bf(silu_n(yv) * silu_n(z));
    }
}

#ifndef FAST_MASK
#define FAST_MASK 31
#endif
#ifndef ONE_LAUNCH
#define ONE_LAUNCH 1
#endif
extern "C" void kernel_launch(void* const* d_in, const int* in_sizes, int n_in, void* d_out, int out_size, void* d_ws, size_t ws_size, hipStream_t stream) {
    static int grid = 0;
    if (grid == 0) {
        if (n_in != 12 || in_sizes[0] != M * D_MODEL || out_size != M * D_MODEL || ws_size < WS_END) { fprintf(stderr, "kernel_launch: unexpected shapes; nothing launched\n"); grid = -1; return; }
        int dev = 0, cus = 0, per_cu = 0;
        if (hipGetDevice(&dev) != hipSuccess || hipDeviceGetAttribute(&cus, hipDeviceAttributeMultiprocessorCount, dev) != hipSuccess) { fprintf(stderr, "kernel_launch: device query failed\n"); grid = -1; return; }
        if (hipFuncSetAttribute((const void*)hymba_fwd, hipFuncAttributeMaxDynamicSharedMemorySize, LDS_BYTES) != hipSuccess) { fprintf(stderr, "kernel_launch: hipFuncSetAttribute failed\n"); grid = -1; return; }
        if (hipOccupancyMaxActiveBlocksPerMultiprocessor(&per_cu, (const void*)hymba_fwd, NWAVES * 64, LDS_BYTES) != hipSuccess || per_cu < 1) { fprintf(stderr, "kernel_launch: occupancy query says %d blocks per CU; nothing launched\n", per_cu); (void)hipGetLastError(); grid = -1; return; }
        grid = cus;
    }
    if (grid < 0) return;
    const float* x = (const float*)d_in[0]; const float* norm_w = (const float*)d_in[1]; const float* w_in = (const float*)d_in[2];
    const float* qnw = (const float*)d_in[3]; const float* knw = (const float*)d_in[4]; const float* sinks = (const float*)d_in[5];
    const float* dww = (const float*)d_in[6]; const float* dwb = (const float*)d_in[7]; const float* lnw = (const float*)d_in[8]; const float* lnb = (const float*)d_in[9];
    const float* w_out = (const float*)d_in[10]; const float* relb = (const float*)d_in[11];
    unsigned char* ws = (unsigned char*)d_ws;
    bf16* WIN = (bf16*)(ws + WS_WIN); bf16* WOUT = (bf16*)(ws + WS_WOUT); bf16* XN = (bf16*)(ws + WS_XN); bf16* P = (bf16*)(ws + WS_P); bf16* Y = (bf16*)(ws + WS_Y);
    float* YC = (float*)(ws + WS_YC);
    Args a{};
    for (int i = 0; i < 12; ++i) a.in[i] = (const float*)d_in[i];
    a.out = (float*)d_out; a.ws = ws; a.p2mask = 3;
    auto launch = [&](int lo, int hi, int p2mask) { a.ph_lo = lo; a.ph_hi = hi; a.p2mask = p2mask; hipLaunchKernelGGL(hymba_fwd, dim3(grid), dim3(NWAVES * 64), LDS_BYTES, stream, a); };
    if (ONE_LAUNCH && FAST_MASK == 31) {
        if (hipMemsetAsync(ws + WS_CTL, 0, CTL_ZERO_BYTES, stream) != hipSuccess) { fprintf(stderr, "kernel_launch: memset failed\n"); return; }
        launch(0, 4, 3);
        return;
    }
    if (FAST_MASK & 1) launch(0, 1, 0);
    else {
        hipLaunchKernelGGL(nv_transpose, dim3((D_MODEL * D_IN + 255) / 256), dim3(256), 0, stream, w_in, D_MODEL, D_IN, WIN);
        hipLaunchKernelGGL(nv_transpose, dim3((D_MODEL * D_MODEL + 255) / 256), dim3(256), 0, stream, w_out, D_MODEL, D_MODEL, WOUT);
        hipLaunchKernelGGL(nv_rmsnorm, dim3(M / 4), dim3(256), 0, stream, x, norm_w, XN);
    }
    if (FAST_MASK & 2) launch(1, 2, 0);
    else hipLaunchKernelGGL(nv_gemm<0>, dim3(D_IN / 64, M / 64), dim3(256), 0, stream, XN, WIN, M, D_IN, D_MODEL, P, (float*)nullptr, (const float*)nullptr);
    if (FAST_MASK & 12) launch(2, 3, (FAST_MASK >> 2) & 3);
    if (!(FAST_MASK & 4)) hipLaunchKernelGGL(nv_attn, dim3(M * N_HEADS / 256), dim3(256), 0, stream, P, qnw, knw, sinks, relb, Y);
    if (!(FAST_MASK & 8)) {
        hipLaunchKernelGGL(nv_conv, dim3(M * D_CONV / 256), dim3(256), 0, stream, P, dww, dwb, YC);
        hipLaunchKernelGGL(nv_ln, dim3(M / 4), dim3(256), 0, stream, YC, P, lnw, lnb, Y);
    }
    if (FAST_MASK & 16) launch(3, 4, 0);
    else hipLaunchKernelGGL(nv_gemm<1>, dim3(D_MODEL / 64, M / 64), dim3(256), 0, stream, Y, WOUT, M, D_MODEL, D_MODEL, (bf16*)nullptr, (float*)d_out, x);
}
```

```cpp
#include <hip/hip_runtime.h>
#include <cstdio>
#include <cstdint>
namespace pg8 {
#define PG8_LAS __attribute__((address_space(3)))
typedef unsigned short bf16_t;
typedef short bf16x8 __attribute__((ext_vector_type(8)));
typedef float f32x4 __attribute__((ext_vector_type(4)));
typedef unsigned u32x4 __attribute__((ext_vector_type(4)));
constexpr int BM = 256, BK = 64, HALF = 128, HTB = HALF * BK * 2  , STAGE_BYTES = 8 * HTB, NXCD = 8, WGM = 8;

__host__ __device__ __forceinline__ int lds_byte(int r, int c) { const int st = (r >> 4) * 2 + (c >> 5), rr = r & 15, cc = c & 31, ob = rr * 64 + cc * 2; return st * 1024 + (ob ^ (((ob >> 9) & 1) << 5)); }
__host__ __device__ __forceinline__ void stage_rc(int b, int& R, int& C) { const int st = b / 1024, sb = b % 1024, swz = sb ^ (((sb >> 9) & 1) << 5); R = (st >> 1) * 16 + swz / 64; C = (st & 1) * 32 + (swz % 64) / 2; }
__host__ __device__ __forceinline__ int perm32(int rho) { const int n = rho >> 4, i = rho & 15; return 8 * (i >> 2) + 4 * n + (i & 3); }

struct Unit { int pm, pn; };
struct Gemm { const bf16_t* A; const bf16_t* Bt; int M, N, K; };

struct StaticOrder {
    int nM, nN, nwg, G, c;
    __host__ __device__ void init(int M, int N, int G_, int c_) { nM = M / BM; nN = N / BM; nwg = nM * nN; G = G_; c = c_; }
    __host__ __device__ bool next(int i, Unit& u) const {
        const long L = (long)i * G + c; if (L >= nwg) return false;
        int wgid = (int)L; { const int q = nwg / NXCD, r = nwg % NXCD, xcd = wgid % NXCD, off = wgid / NXCD; wgid = (xcd < r ? xcd * (q + 1) : r * (q + 1) + (xcd - r) * q) + off; }
        const int nig = WGM * nN, gid = wgid / nig, fm = gid * WGM, gsz = (nM - fm) < WGM ? (nM - fm) : WGM;
        u.pm = fm + ((wgid % nig) % gsz); u.pn = (wgid % nig) / gsz; return true;
    }
    __device__ __forceinline__ void a_ready(const Unit&) const {}
    __device__ __forceinline__ void done(const Unit&) const {}
};

__device__ __forceinline__ unsigned cvt_pk_bf16(float lo, float hi) { unsigned r; asm volatile("v_cvt_pk_bf16_f32 %0, %1, %2" : "=v"(r) : "v"(lo), "v"(hi)); return r; }
typedef float f32x2 __attribute__((ext_vector_type(2)));
__device__ __forceinline__ f32x2 gelu_pk(f32x2 v) {
    const f32x2 av = __builtin_elementwise_abs(v), d = av * 0.2316418882f + 1.0f;
    f32x2 t; t.x = __builtin_amdgcn_rcpf(d.x); t.y = __builtin_amdgcn_rcpf(d.y);
    f32x2 q = t * 0.5307027145f + (-0.7265760135f); q = q * t + 0.7107068705f; q = q * t + (-0.142248368f); q = q * t + 0.127414796f; q = q * t;
    const f32x2 s = (v * v) * (-0.72134752044f);
    f32x2 e; e.x = __builtin_amdgcn_exp2f(s.x); e.y = __builtin_amdgcn_exp2f(s.y);
    const f32x2 m = v * (q * e), r = v - m;
    f32x2 o; o.x = v.x < 0.f ? m.x : r.x; o.y = v.y < 0.f ? m.y : r.y; return o;
}

template <int ACT  > struct EpiBf16 {
    static constexpr bool PERM = true, AFTER_DRAIN = false; static_assert(ACT == 0 || ACT == 1, "EpiBf16: ACT is 0 (none) or 1 (gelu_pk)");
    __device__ __forceinline__ void init(f32x4 (&acc)[2][2][4][2], const Unit&, int, int, int, int) const {
#pragma unroll
        for (int a = 0; a < 2; ++a)
#pragma unroll
            for (int b = 0; b < 2; ++b)
#pragma unroll
                for (int m = 0; m < 4; ++m)
#pragma unroll
                    for (int n = 0; n < 2; ++n) acc[a][b][m][n] = (f32x4){0.f, 0.f, 0.f, 0.f}; }
    bf16_t* O; int ldc; const float* bias; int split_cols; size_t split_stride; float scale0;
    __device__ __forceinline__ void operator()(const f32x4 (&acc)[2][2][4][2], const Unit& u, int wr, int wc, int fr, int fq) const {
        const int row0 = u.pm * BM + wr * 64 + fr; int colt = u.pn * BM; bf16_t* base = O;
        float sc = 1.f; if (split_cols) { const int t = colt / split_cols; base += (size_t)t * split_stride; colt -= t * split_cols; if (t == 0) sc = scale0; }
        const int col0 = colt + wc * 32 + 8 * fq, bcol0 = u.pn * BM + wc * 32 + 8 * fq;
        f32x4 bv[2][2];
#pragma unroll
        for (int bj = 0; bj < 2; ++bj)
#pragma unroll
            for (int n = 0; n < 2; ++n) bv[bj][n] = bias ? *(const f32x4*)(bias + bcol0 + bj * HALF + 4 * n) : (f32x4){0.f, 0.f, 0.f, 0.f};
#pragma unroll
        for (int ai = 0; ai < 2; ++ai)
#pragma unroll
            for (int m = 0; m < 4; ++m) { bf16_t* rowp = base + (size_t)(row0 + ai * HALF + m * 16) * ldc + col0;
#pragma unroll
                for (int bj = 0; bj < 2; ++bj) { f32x4 v0 = acc[ai][bj][m][0] + bv[bj][0], v1 = acc[ai][bj][m][1] + bv[bj][1];
                    if (ACT == 1) { f32x2 a = gelu_pk((f32x2){v0[0], v0[1]}), b = gelu_pk((f32x2){v0[2], v0[3]}), c = gelu_pk((f32x2){v1[0], v1[1]}), d = gelu_pk((f32x2){v1[2], v1[3]});
                        v0 = (f32x4){a.x, a.y, b.x, b.y}; v1 = (f32x4){c.x, c.y, d.x, d.y}; }
                    v0 = v0 * sc; v1 = v1 * sc; u32x4 w; w.x = cvt_pk_bf16(v0[0], v0[1]); w.y = cvt_pk_bf16(v0[2], v0[3]); w.z = cvt_pk_bf16(v1[0], v1[1]); w.w = cvt_pk_bf16(v1[2], v1[3]);
                    *(u32x4*)(rowp + bj * HALF) = w; } }
    }
};
struct EpiResF32 {
    static constexpr bool PERM = false, AFTER_DRAIN = false;
    float* C; const float* R; int ldc;
    __device__ __forceinline__ void init(f32x4 (&acc)[2][2][4][2], const Unit& u, int wr, int wc, int fr, int fq) const {
        const int row0 = u.pm * BM + wr * 64 + fr, col0 = u.pn * BM + wc * 32 + 4 * fq;
#pragma unroll
        for (int ai = 0; ai < 2; ++ai)
#pragma unroll
            for (int m = 0; m < 4; ++m) { const size_t off = (size_t)(row0 + ai * HALF + m * 16) * ldc + col0;
#pragma unroll
                for (int bj = 0; bj < 2; ++bj)
#pragma unroll
                    for (int n = 0; n < 2; ++n) acc[ai][bj][m][n] = *(const f32x4*)(R + off + bj * HALF + n * 16); }
    }
    __device__ __forceinline__ void operator()(const f32x4 (&acc)[2][2][4][2], const Unit& u, int wr, int wc, int fr, int fq) const {
        const int row0 = u.pm * BM + wr * 64 + fr, col0 = u.pn * BM + wc * 32 + 4 * fq;
#pragma unroll
        for (int ai = 0; ai < 2; ++ai)
#pragma unroll
            for (int m = 0; m < 4; ++m) { const size_t off = (size_t)(row0 + ai * HALF + m * 16) * ldc + col0;
#pragma unroll
                for (int bj = 0; bj < 2; ++bj)
#pragma unroll
                    for (int n = 0; n < 2; ++n) *(f32x4*)(C + off + bj * HALF + n * 16) = acc[ai][bj][m][n]; }
    }
};
struct EpiProj {
    static constexpr bool PERM = true, AFTER_DRAIN = false;
    bf16_t* O;
    __device__ __forceinline__ void init(f32x4 (&acc)[2][2][4][2], const Unit&, int, int, int, int) const {
#pragma unroll
        for (int a = 0; a < 2; ++a)
#pragma unroll
            for (int b = 0; b < 2; ++b)
#pragma unroll
                for (int m = 0; m < 4; ++m)
#pragma unroll
                    for (int n = 0; n < 2; ++n) acc[a][b][m][n] = (f32x4){0.f, 0.f, 0.f, 0.f}; }
    __device__ __forceinline__ void operator()(const f32x4 (&acc)[2][2][4][2], const Unit& u, int wr, int wc, int fr, int fq) const {
        constexpr int LDP = 2304; typedef unsigned u32x2 __attribute__((ext_vector_type(2)));
        const int row0 = u.pm * BM + wr * 64 + fr, pn = u.pn;
        if (pn >= 5 && pn < 9) {
            const int ch0 = 1280 + 128 * (pn - 5) + 16 * wc + 4 * fq;
#pragma unroll
            for (int ai = 0; ai < 2; ++ai)
#pragma unroll
                for (int m = 0; m < 4; ++m) { bf16_t* rowp = O + (size_t)(row0 + ai * HALF + m * 16) * LDP + ch0;
#pragma unroll
                    for (int bj = 0; bj < 2; ++bj) { const f32x4 a = acc[ai][bj][m][0], g = acc[ai][bj][m][1]; f32x4 s;
#pragma unroll
                        for (int e = 0; e < 4; ++e) s[e] = a[e] * __builtin_amdgcn_rcpf(1.0f + __builtin_amdgcn_exp2f(-1.4426950408889634f * g[e]));
                        u32x2 w; w.x = cvt_pk_bf16(s[0], s[1]); w.y = cvt_pk_bf16(s[2], s[3]);
                        *(u32x2*)(rowp + bj * 64) = w; } }
        } else {
            const int col0 = (pn < 5 ? pn * BM : 1792 + (pn - 9) * BM) + wc * 32 + 8 * fq;
#pragma unroll
            for (int ai = 0; ai < 2; ++ai)
#pragma unroll
                for (int m = 0; m < 4; ++m) { bf16_t* rowp = O + (size_t)(row0 + ai * HALF + m * 16) * LDP + col0;
#pragma unroll
                    for (int bj = 0; bj < 2; ++bj) { const f32x4 v0 = acc[ai][bj][m][0], v1 = acc[ai][bj][m][1];
                        u32x4 w; w.x = cvt_pk_bf16(v0[0], v0[1]); w.y = cvt_pk_bf16(v0[2], v0[3]); w.z = cvt_pk_bf16(v1[0], v1[1]); w.w = cvt_pk_bf16(v1[2], v1[3]);
                        *(u32x4*)(rowp + bj * HALF) = w; } }
        }
    }
};
template <class Epi, class Sched, bool ALIGN_EPI = false, bool SP2 = false>
__device__ __forceinline__ void gemm_phase(PG8_LAS unsigned char* lds, const Gemm g, const Sched& S, const Epi& E) {
    const int tid = threadIdx.x, wid = __builtin_amdgcn_readfirstlane(tid >> 6), lane = tid & 63, wr = wid >> 2, wc = wid & 3, fr = lane & 15, fq = lane >> 4;
    const int K = g.K, nt = K / BK;
    unsigned voffA[2], voffB[2];
#pragma unroll
    for (int i = 0; i < 2; ++i) { int R, C; stage_rc(tid * 16 + i * 8192, R, C); const int Rb = Epi::PERM ? ((R & ~31) + perm32(R & 31)) : R;
        voffA[i] = (unsigned)(R * K + C) * 2u; voffB[i] = (unsigned)(Rb * K + C) * 2u; }
    const size_t kstep = (size_t)(BK * 2);
    const size_t hstep = (size_t)HALF * K * 2;
    const size_t tstep = 2 * hstep;
    const unsigned ldsw = (unsigned)wid * 1024u;
    const int aoff = lds_byte(wr * 64 + fr, fq * 8), boff = lds_byte(wc * 32 + fr, fq * 8);
#define PG8_SA(b, h) (((b) * 2 + (h)) * HTB)
#define PG8_SB(b, h) ((4 + (b) * 2 + (h)) * HTB)
#define PG8_STAGE(bufoff, gbase, voff) do { _Pragma("unroll") for (int _i = 0; _i < 2; ++_i) \
        __builtin_amdgcn_global_load_lds((const unsigned*)((const char*)(gbase) + (voff)[_i]), (PG8_LAS unsigned*)(lds + (bufoff) + ldsw + _i * 8192), 16, 0, 0); } while (0)
#define PG8_LDA(dst, b, h) do { _Pragma("unroll") for (int m = 0; m < 4; ++m) _Pragma("unroll") for (int k = 0; k < 2; ++k) dst[m][k] = *(const PG8_LAS bf16x8*)(lds + PG8_SA(b, h) + aoff + m * 2048 + k * 1024); } while (0)
#define PG8_LDB(dst, b, h) do { _Pragma("unroll") for (int n = 0; n < 2; ++n) _Pragma("unroll") for (int k = 0; k < 2; ++k) dst[n][k] = *(const PG8_LAS bf16x8*)(lds + PG8_SB(b, h) + boff + n * 2048 + k * 1024); } while (0)
#define PG8_MMA(ai, bj, At, Bt) do { __builtin_amdgcn_s_setprio(1); _Pragma("unroll") for (int m = 0; m < 4; ++m) _Pragma("unroll") for (int n = 0; n < 2; ++n) _Pragma("unroll") for (int k = 0; k < 2; ++k) \
        acc[ai][bj][m][n] = __builtin_amdgcn_mfma_f32_16x16x32_bf16(Bt[n][k], At[m][k], acc[ai][bj][m][n], 0, 0, 0); __builtin_amdgcn_s_setprio(0); } while (0)
#define PG8_WAIT_V(n) asm volatile("s_waitcnt vmcnt(" #n ")" ::: "memory")
#define PG8_WAIT_L(n) asm volatile("s_waitcnt lgkmcnt(" #n ")" ::: "memory")
#define PG8_BAR __builtin_amdgcn_s_barrier()
#define PG8_SCHED __builtin_amdgcn_sched_barrier(0)
    Unit cur, nxt; int ui = 0;
    if (!S.next(0, cur)) return;
    f32x4 acc[2][2][4][2];
    E.init(acc, cur, wr, wc, fr, fq);
    bf16x8 At[4][2], B0[2][2], B1[2][2];
    const char* cA = (const char*)g.A + (size_t)cur.pm * tstep; const char* cB = (const char*)g.Bt + (size_t)cur.pn * tstep;
    S.a_ready(cur);
    if constexpr (SP2) {
        PG8_STAGE(PG8_SB(0, 0), cB, voffB); PG8_STAGE(PG8_SB(0, 1), cB + hstep, voffB); PG8_STAGE(PG8_SA(0, 0), cA, voffA); PG8_STAGE(PG8_SA(0, 1), cA + hstep, voffA);
        if (wr == 1) PG8_BAR;
        PG8_WAIT_V(2); PG8_BAR;
        PG8_STAGE(PG8_SB(1, 0), cB + kstep, voffB); PG8_STAGE(PG8_SA(1, 0), cA + kstep, voffA); PG8_STAGE(PG8_SB(1, 1), cB + hstep + kstep, voffB);
        PG8_WAIT_V(6); PG8_BAR;
    } else {
        PG8_STAGE(PG8_SB(0, 0), cB, voffB); PG8_STAGE(PG8_SA(0, 0), cA, voffA); PG8_STAGE(PG8_SB(0, 1), cB + hstep, voffB); PG8_STAGE(PG8_SA(0, 1), cA + hstep, voffA);
        if (wr == 1) PG8_BAR;
        PG8_WAIT_V(4); PG8_BAR;
        PG8_STAGE(PG8_SB(1, 0), cB + kstep, voffB); PG8_STAGE(PG8_SA(1, 0), cA + kstep, voffA); PG8_STAGE(PG8_SB(1, 1), cB + hstep + kstep, voffB);
        PG8_WAIT_V(6); PG8_BAR;
    }
    for (;;) {
        const bool has_next = S.next(ui + 1, nxt);
        const char* nA = has_next ? (const char*)g.A + (size_t)nxt.pm * tstep : cA; const char* nB = has_next ? (const char*)g.Bt + (size_t)nxt.pn * tstep : cB;
        for (int t = 0; t < nt; t += 2) {
            const bool last = (t == nt - 2);
            const char* a1 = cA + (size_t)(t + 1) * kstep;
            const char* a2 = last ? nA : cA + (size_t)(t + 2) * kstep; const char* b2 = last ? nB : cB + (size_t)(t + 2) * kstep;
            const char* a3 = a2 + kstep; const char* b3 = b2 + kstep;
            if (last && has_next) S.a_ready(nxt);
            if constexpr (SP2) {
            PG8_LDB(B0, 0, 0); PG8_LDB(B1, 0, 1); PG8_SCHED; PG8_LDA(At, 0, 0); PG8_STAGE(PG8_SA(1, 1), a1 + hstep, voffA);
            PG8_WAIT_V(8); PG8_WAIT_L(0); PG8_BAR; PG8_MMA(0, 0, At, B0); PG8_MMA(0, 1, At, B1); PG8_BAR; PG8_SCHED;
            PG8_LDA(At, 0, 1); PG8_STAGE(PG8_SB(0, 0), b2, voffB); PG8_STAGE(PG8_SB(0, 1), b2 + hstep, voffB); PG8_STAGE(PG8_SA(0, 0), a2, voffA);
            PG8_WAIT_V(8); PG8_WAIT_L(0); PG8_BAR; PG8_MMA(1, 0, At, B0); PG8_MMA(1, 1, At, B1); PG8_BAR; PG8_SCHED;
            PG8_LDB(B0, 1, 0); PG8_LDB(B1, 1, 1); PG8_SCHED; PG8_LDA(At, 1, 0); PG8_STAGE(PG8_SA(0, 1), a2 + hstep, voffA);
            PG8_WAIT_V(8); PG8_WAIT_L(0); PG8_BAR; PG8_MMA(0, 0, At, B0); PG8_MMA(0, 1, At, B1); PG8_BAR; PG8_SCHED;
            PG8_LDA(At, 1, 1); PG8_STAGE(PG8_SB(1, 0), b3, voffB); PG8_STAGE(PG8_SB(1, 1), b3 + hstep, voffB); PG8_STAGE(PG8_SA(1, 0), a3, voffA);
            PG8_WAIT_V(8); PG8_WAIT_L(0); PG8_BAR; PG8_MMA(1, 0, At, B0); PG8_MMA(1, 1, At, B1); PG8_BAR; PG8_SCHED;
            } else {
            PG8_LDB(B0, 0, 0); PG8_SCHED; PG8_LDA(At, 0, 0); PG8_STAGE(PG8_SA(1, 1), a1 + hstep, voffA);
            PG8_WAIT_L(8); PG8_BAR; PG8_WAIT_L(0); PG8_MMA(0, 0, At, B0); PG8_BAR; PG8_SCHED;
            PG8_LDB(B1, 0, 1); PG8_STAGE(PG8_SB(0, 0), b2, voffB);
            PG8_BAR; PG8_WAIT_L(0); PG8_MMA(0, 1, At, B1); PG8_BAR;
            PG8_LDA(At, 0, 1); PG8_STAGE(PG8_SA(0, 0), a2, voffA);
            PG8_BAR; PG8_WAIT_L(0); PG8_MMA(1, 0, At, B0); PG8_BAR; PG8_SCHED;
            PG8_STAGE(PG8_SB(0, 1), b2 + hstep, voffB);
            PG8_WAIT_V(6); PG8_BAR; PG8_MMA(1, 1, At, B1); PG8_BAR;
            PG8_LDB(B0, 1, 0); PG8_SCHED; PG8_LDA(At, 1, 0); PG8_STAGE(PG8_SA(0, 1), a2 + hstep, voffA);
            PG8_WAIT_L(8); PG8_BAR; PG8_WAIT_L(0); PG8_MMA(0, 0, At, B0); PG8_BAR; PG8_SCHED;
            PG8_LDB(B1, 1, 1); PG8_STAGE(PG8_SB(1, 0), b3, voffB);
            PG8_BAR; PG8_WAIT_L(0); PG8_MMA(0, 1, At, B1); PG8_BAR;
            PG8_LDA(At, 1, 1); PG8_STAGE(PG8_SA(1, 0), a3, voffA);
            PG8_BAR; PG8_WAIT_L(0); PG8_MMA(1, 0, At, B0); PG8_BAR; PG8_SCHED;
            PG8_STAGE(PG8_SB(1, 1), b3 + hstep, voffB);
            PG8_WAIT_V(6); PG8_BAR; PG8_MMA(1, 1, At, B1); PG8_BAR;
            }
        }
        if constexpr (ALIGN_EPI) { if (wr == 0) PG8_BAR; }
        if constexpr (!Epi::AFTER_DRAIN) { E(acc, cur, wr, wc, fr, fq); S.done(cur); }
        if (!has_next) break;
        E.init(acc, nxt, wr, wc, fr, fq);
        cur = nxt; cA = nA; cB = nB; ++ui;
        if constexpr (ALIGN_EPI) { if (wr == 1) PG8_BAR; }
    }
    PG8_WAIT_V(0);
    if constexpr (!ALIGN_EPI) { if (wr == 0) PG8_BAR; }
    PG8_BAR;
    if constexpr (Epi::AFTER_DRAIN) { E.fused(acc, cur, wr, wc, fr, fq, lds, wid, lane); S.done(cur); }
#undef PG8_SA
#undef PG8_SB
#undef PG8_STAGE
#undef PG8_LDA
#undef PG8_LDB
#undef PG8_MMA
#undef PG8_WAIT_V
#undef PG8_WAIT_L
#undef PG8_BAR
#undef PG8_SCHED
}
}

#ifndef PG8_SP2
#define PG8_SP2 true
#endif
#ifndef PG8_ALIGN
#define PG8_ALIGN true
#endif
#define GAS __attribute__((address_space(1)))
#define LAS __attribute__((address_space(3)))
typedef unsigned short bf16;
typedef unsigned v4u __attribute__((ext_vector_type(4)));
typedef float f32x4 __attribute__((ext_vector_type(4)));
typedef short bf16x8 __attribute__((ext_vector_type(8)));
typedef GAS unsigned gu32;
typedef GAS unsigned long long gu64;
#define RLX_AGENT __ATOMIC_RELAXED, __HIP_MEMORY_SCOPE_AGENT
#define LDS_WAIT() asm volatile("s_waitcnt lgkmcnt(0)" ::: "memory")
#define VM_WAIT() asm volatile("s_waitcnt vmcnt(0)" ::: "memory")
__device__ __forceinline__ unsigned long long rt() { return __builtin_amdgcn_s_memrealtime(); }
__device__ __forceinline__ unsigned f2bf(float f) { unsigned u = __builtin_bit_cast(unsigned, f); return (u + 0x7fffu + ((u >> 16) & 1u)) >> 16; }
typedef float pk_f32x2_t __attribute__((ext_vector_type(2))); typedef __bf16 pk_bf16x2_t __attribute__((ext_vector_type(2)));
__device__ __forceinline__ unsigned pk2(float lo, float hi) { pk_f32x2_t v = {lo, hi}; pk_bf16x2_t b = __builtin_convertvector(v, pk_bf16x2_t); return __builtin_bit_cast(unsigned, b); }

#define XB_TMO      128
#define XB_XCNT(j)  (256  + 64 * (j))
#define XB_XSUB(j)  (1280 + 64 * (j))
#define XB_XGEN(j)  (2304 + 64 * (j))
#define XB_TOP      3328
#define XB_TOPGEN   3392
#define XCD_BAR_WORDS 3456
#define XB_SPIN_CAP (1u << 18)

__device__ __forceinline__ unsigned xb_ld(unsigned* p)              { return __hip_atomic_load(p, __ATOMIC_RELAXED, __HIP_MEMORY_SCOPE_AGENT); }
__device__ __forceinline__ unsigned xb_add(unsigned* p, unsigned v) { return __hip_atomic_fetch_add(p, v, __ATOMIC_RELAXED, __HIP_MEMORY_SCOPE_AGENT); }
__device__ __forceinline__ unsigned xb_xcc_id() { return (unsigned)__builtin_amdgcn_s_getreg((3 << 11) | 20) & 0xFu; }
#define XB_SPIN(cond, bar) do { unsigned _sp = 0; while (cond) { __builtin_amdgcn_s_sleep(1); \
    if ((++_sp & 255u) == 0u) { if (xb_ld(&(bar)[XB_TMO])) break; if (_sp > XB_SPIN_CAP) { atomicAdd(&(bar)[XB_TMO], 1u); break; } } } } while (0)

struct XcdBarrier {
    unsigned* bar; unsigned x;
    volatile LAS unsigned* st;
};

__device__ __forceinline__ XcdBarrier xcd_barrier_post(unsigned* bar, volatile LAS unsigned* st) {
    XcdBarrier b; b.bar = bar; b.x = xb_xcc_id(); b.st = st;
    if (threadIdx.x == 0) (void)xb_add(&bar[XB_XCNT(b.x)], 1u);
    return b;
}
__device__ __forceinline__ void xcd_barrier_complete(unsigned* bar, unsigned x, unsigned& nloc, unsigned& nx) {
    const unsigned G = gridDim.x * gridDim.y * gridDim.z;
    unsigned sum, cnt, mine, sp = 0u;
    for (;;) {
        sum = 0u; cnt = 0u; mine = 0u;
#pragma unroll
        for (unsigned j = 0; j < 16; ++j) { const unsigned c = xb_ld(&bar[XB_XCNT(j)]); sum += c; cnt += (c > 0u) ? 1u : 0u; mine = (j == x) ? c : mine; }
        if (sum == G) break;
        __builtin_amdgcn_s_sleep(1);
        if ((++sp & 255u) == 0u) { if (xb_ld(&bar[XB_TMO])) break; if (sp > XB_SPIN_CAP) { atomicAdd(&bar[XB_TMO], 1u); break; } }
    }
    nloc = mine > 0u ? mine : 1u; nx = cnt > 0u ? cnt : 1u;
}

__device__ __forceinline__ void xcd_barrier(const XcdBarrier& b) {
    asm volatile("s_waitcnt vmcnt(0)" ::: "memory");
    __syncthreads();
    if (threadIdx.x == 0) {
        unsigned* bar = b.bar;
        __builtin_amdgcn_s_waitcnt(0);
        unsigned nloc = b.st[0], nx = b.st[1];
        if (nloc == 0u) { xcd_barrier_complete(bar, b.x, nloc, nx); b.st[0] = nloc; b.st[1] = nx; }
        const unsigned old = xb_add(&bar[XB_XSUB(b.x)], 1u);
        const unsigned gen = old / nloc;
        if (old + 1u == (gen + 1u) * nloc) {
            __builtin_amdgcn_fence(__ATOMIC_RELEASE, "agent");
            asm volatile("s_waitcnt vmcnt(0)" ::: "memory");
            const unsigned og = xb_add(&bar[XB_TOP], 1u);
            const unsigned tg = og / nx;
            if (og + 1u == (tg + 1u) * nx) xb_add(&bar[XB_TOPGEN], 1u);
            else XB_SPIN(xb_ld(&bar[XB_TOPGEN]) == tg, bar);
            __builtin_amdgcn_fence(__ATOMIC_ACQUIRE, "agent");
            xb_add(&bar[XB_XGEN(b.x)], 1u);
            asm volatile("s_waitcnt vmcnt(0)" ::: "memory");
        } else {
            XB_SPIN(xb_ld(&bar[XB_XGEN(b.x)]) == gen, bar);
            __builtin_amdgcn_fence(__ATOMIC_ACQUIRE, "agent");
            asm volatile("s_waitcnt vmcnt(0)" ::: "memory");
        }
    }
    __syncthreads();
}

constexpr int NWAVES = 8;
constexpr int D_MODEL = 1024, BATCH = 4, SEQ = 4096, M = BATCH * SEQ;
constexpr int N_HEADS = 8, GQA = 4, WINDOW = 128;
constexpr int D_ATTN = 512, D_CONV = 512, CONVW = 31;
constexpr int D_IN = 2816;
constexpr int D_P = 2304;
constexpr int C_Q = 0, C_K = 512, C_V = 640, C_ZA = 768, C_U = 1280, C_ZC = 1792;
constexpr int V_GLU = 1280, V_ZC = 2304;
constexpr float EPS = 1e-6f, LN_EPS = 1e-5f;
constexpr float LOG2E = 1.4426950408889634f;
constexpr float NEG_BIG = -1e30f;

constexpr size_t MiB = 1u << 20;
constexpr size_t WS_CTL = 0, CTL_ZERO_BYTES = 64 * 1024;
constexpr size_t WS_WIN = 2 * MiB;
constexpr size_t WS_WOUT = 8 * MiB;
constexpr size_t WS_XN = 16 * MiB;
constexpr size_t WS_P = 48 * MiB;
constexpr size_t WS_Y = 136 * MiB;
constexpr size_t WS_YC = 168 * MiB;
constexpr size_t WS_END = 200 * MiB;
constexpr int CW_BAR = 1024;
static_assert((CW_BAR + XCD_BAR_WORDS) * 4 <= (int)CTL_ZERO_BYTES, "control words inside the memset region");

constexpr int RING_BYTES = 131072;
constexpr int MISC_OFF = 163328;
constexpr int LDS_BYTES = 163840;

typedef float f32x16 __attribute__((ext_vector_type(16)));
typedef float f32x2 __attribute__((ext_vector_type(2)));
typedef short s16x4 __attribute__((ext_vector_type(4)));
typedef short v4i16_t __attribute__((ext_vector_type(4)));
typedef unsigned u32x2 __attribute__((ext_vector_type(2)));

__device__ __forceinline__ float bf_lo(unsigned w) { return __builtin_bit_cast(float, w << 16); }
__device__ __forceinline__ float bf_hi(unsigned w) { return __builtin_bit_cast(float, w & 0xffff0000u); }
__device__ __forceinline__ float silu_f(float z) { return z * __builtin_amdgcn_rcpf(1.0f + __builtin_amdgcn_exp2f(-LOG2E * z)); }
__device__ __forceinline__ float sigmoid_f(float z) { return __builtin_amdgcn_rcpf(1.0f + __builtin_amdgcn_exp2f(-LOG2E * z)); }
__device__ __forceinline__ float wave_sum(float v) {
#pragma unroll
    for (int o = 1; o < 64; o <<= 1) v += __shfl_xor(v, o);
    return v;
}
__device__ __forceinline__ float hsum32(float v) {
    auto rr = __builtin_amdgcn_permlane32_swap(__float_as_uint(v), __float_as_uint(v), false, false);
    return __uint_as_float(rr[0]) + __uint_as_float(rr[1]);
}
__device__ __forceinline__ float hmax32(float v) {
    auto rr = __builtin_amdgcn_permlane32_swap(__float_as_uint(v), __float_as_uint(v), false, false);
    return fmaxf(__uint_as_float(rr[0]), __uint_as_float(rr[1]));
}
__device__ __forceinline__ int t5_bucket(int dist) {
    if (dist < 16) return dist;
    const float nf = (float)dist;
    int large = 16 + (int)(logf(nf / 16.0f) / 2.0794415416798357f * 16.0f);
    return large < 31 ? large : 31;
}

__device__ __forceinline__ int win_srccol(int v) {
    if (v < V_GLU || v >= V_ZC) return v;
    const int k = (v - V_GLU) >> 3, j = (v - V_GLU) & 7;
    return (j < 4) ? (1280 + 4 * k + j) : (1792 + 4 * k + (j - 4));
}
template <bool VIRT>
__device__ __forceinline__ void p0_transpose_item(const float* W, int K, int N, bf16* WT, LAS float* scr, int item, int lane) {
    const int nblk = N / 32, kb = item / nblk, nb = item % nblk, k0 = 64 * kb, n0 = 32 * nb;
    const int sc = VIRT ? win_srccol(n0 + (lane & 31)) : (n0 + (lane & 31));
#pragma unroll 8
    for (int i = 0; i < 32; ++i) { const int kk = 2 * i + (lane >> 5); scr[kk * 33 + (lane & 31)] = W[(size_t)(k0 + kk) * N + sc]; }
    LDS_WAIT(); asm volatile("" ::: "memory");
    const int c = lane & 7;
#pragma unroll
    for (int j = 0; j < 4; ++j) { const int n = (lane >> 3) + 8 * j; const LAS float* s = scr + (8 * c) * 33 + n;
        v4u o; o.x = pk2(s[0 * 33], s[1 * 33]); o.y = pk2(s[2 * 33], s[3 * 33]); o.z = pk2(s[4 * 33], s[5 * 33]); o.w = pk2(s[6 * 33], s[7 * 33]);
        *(GAS v4u*)(WT + (size_t)(n0 + n) * K + k0 + 8 * c) = o; }
    LDS_WAIT(); asm volatile("" ::: "memory");
}
__device__ __forceinline__ void p0_prologue(LAS unsigned char* lds, int gw, int NGW, int wave, int lane, const float* x, const float* norm_w, const float* w_in, const float* w_out, bf16* WIN, bf16* WOUT, bf16* XN) {
    LAS float* scr = (LAS float*)(lds + wave * 16384);
    constexpr int I_IN = (D_MODEL / 64) * (D_IN / 32), I_OUT = (D_MODEL / 64) * (D_MODEL / 32);
    for (int it = gw; it < I_IN + I_OUT; it += NGW) {
        if (it < I_IN) p0_transpose_item<true>(w_in, D_MODEL, D_IN, WIN, scr, it, lane);
        else p0_transpose_item<false>(w_out, D_MODEL, D_MODEL, WOUT, scr, it - I_IN, lane);
    }
    f32x4 nw[4];
#pragma unroll
    for (int j = 0; j < 4; ++j) nw[j] = *((const GAS f32x4*)norm_w + lane + 64 * j);
    for (int m = gw; m < M; m += NGW) {
        const GAS f32x4* xr = (const GAS f32x4*)(x + (size_t)m * D_MODEL) + lane;
        f32x4 v[4]; float s = 0.f;
#pragma unroll
        for (int j = 0; j < 4; ++j) { v[j] = xr[64 * j]; s += (v[j].x * v[j].x + v[j].y * v[j].y) + (v[j].z * v[j].z + v[j].w * v[j].w); }
        const float rs = 1.0f / sqrtf(wave_sum(s) * (1.0f / D_MODEL) + EPS);
        GAS unsigned long long* o8 = (GAS unsigned long long*)(XN + (size_t)m * D_MODEL) + lane;
#pragma unroll
        for (int j = 0; j < 4; ++j) { const f32x4 y = v[j] * rs * nw[j]; o8[64 * j] = (unsigned long long)pk2(y.x, y.y) | ((unsigned long long)pk2(y.z, y.w) << 32); }
    }
}

constexpr int AT_K = 0, AT_V = 32768, AT_VPLANE = 16384, AT_TAB = 65536, AT_QNW = 68608, CV_U = 0, CV_UROWS = 64 + CONVW - 1, CV_UBYTES = CV_UROWS * 1024, P2_B = CV_UBYTES, CV_PART = 0, CV_STAT = 4096, PF_SCRATCH = 161792;
static_assert(AT_QNW + 256 <= CV_UBYTES && P2_B + 65536 <= MISC_OFF && P2_B % 16 == 0, "P2 LDS map");
__device__ __forceinline__ int crow(int r, int hi) { return (r & 3) + 8 * (r >> 2) + 4 * hi; }
__device__ __forceinline__ s16x4 vtr(const LAS unsigned char* p) { return __builtin_bit_cast(s16x4, __builtin_amdgcn_ds_read_tr16_b64_v4i16((LAS v4i16_t*)p)); }
__device__ __forceinline__ void dma16(const void* gsrc_lane, LAS unsigned char* lds_wave_base) {
    __builtin_amdgcn_global_load_lds((const GAS unsigned*)gsrc_lane, (LAS unsigned*)lds_wave_base, 16, 0, 0);
}
__device__ __forceinline__ void dma16_asm(const void* gsrc_lane, unsigned lds_dst_wave) { unsigned keep;
    asm volatile("s_mov_b32 %0, m0\n\ts_mov_b32 m0, %2\n\ts_nop 0\n\tglobal_load_lds_dwordx4 %1, off\n\ts_mov_b32 m0, %0" : "=&s"(keep) : "v"(gsrc_lane), "s"(lds_dst_wave) : "memory"); }
__device__ __forceinline__ void prefetch_line_asm(const void* gsrc_lane, unsigned lds_scratch) { unsigned keep;
    asm volatile("s_mov_b32 %0, m0\n\ts_mov_b32 m0, %2\n\ts_nop 0\n\tglobal_load_lds_dword %1, off\n\ts_mov_b32 m0, %0" : "=&s"(keep) : "v"(gsrc_lane), "s"(lds_scratch) : "memory"); }
__device__ __forceinline__ float wave_transpose_sum64(float (&v)[64], int lane) {
#pragma unroll
    for (int i = 0; i < 32; ++i) { auto r = __builtin_amdgcn_permlane32_swap(__float_as_uint(v[i]), __float_as_uint(v[i + 32]), false, false); v[i] = __uint_as_float(r[0]) + __uint_as_float(r[1]); }
#pragma unroll
    for (int i = 0; i < 16; ++i) { auto r = __builtin_amdgcn_permlane16_swap(__float_as_uint(v[i]), __float_as_uint(v[i + 16]), false, false); v[i] = __uint_as_float(r[0]) + __uint_as_float(r[1]); }
#define WTS_STAGE(K) { const bool up = (lane & (K)) != 0; _Pragma("unroll") for (int i = 0; i < (K); ++i) { const float keep = up ? v[i + (K)] : v[i], send = up ? v[i] : v[i + (K)]; v[i] = keep + __shfl_xor(send, (K)); } }
    WTS_STAGE(8) WTS_STAGE(4) WTS_STAGE(2) WTS_STAGE(1)
#undef WTS_STAGE
    return v[0];
}

template <int STEP> struct ConvStep {
    static __device__ __forceinline__ void run(float (&acc)[CONVW], float (&yv)[64], const float (&w)[CONVW], const LAS unsigned short* ub, float cbias) {
        constexpr int s = STEP % CONVW;
        const float u = __builtin_bit_cast(float, (unsigned)ub[STEP * 512] << 16);
#pragma unroll
        for (int i = 0; i < CONVW; ++i) if (STEP + i >= CONVW - 1 && STEP + i - (CONVW - 1) < 64) acc[(i + s) % CONVW] += u * w[CONVW - 1 - i];
        if constexpr (STEP >= CONVW - 1) yv[STEP - (CONVW - 1)] = acc[s] + cbias;
        acc[s] = 0.f;
        if constexpr (STEP + 1 < CV_UROWS) ConvStep<STEP + 1>::run(acc, yv, w, ub, cbias);
    }
};
__device__ __forceinline__ void p2_unit(LAS unsigned char* lds, int unit, int tid, int lane, int wid, const bf16* P, bf16* Y,
                                        const float* qnw, const float* knw, const float* sinks, const float* relb,
                                        const float* dww, const float* dwb, const float* lnw, const float* lnb, const float* xpf) {
    const int kvh = unit & 1, nb = (unit >> 1) & 31, b = unit >> 6;
    const int row0 = b * SEQ + nb * 128;
    const int g = wid >> 1, h = kvh * 4 + g, r32 = lane & 31, hi = lane >> 5;
    v4u kraw[4], vraw[4];
#pragma unroll
    for (int i = 0; i < 4; ++i) {
        const int idx = tid + 512 * i, s = idx >> 3, ch = idx & 7;
        const bool valid = (nb > 0) || (s >= 128);
        const bf16* pr = P + (size_t)(valid ? row0 - 128 + s : row0) * D_P + kvh * 64 + ch * 8;
        kraw[i] = *(const GAS v4u*)(pr + C_K); vraw[i] = *(const GAS v4u*)(pr + C_V);
    }
    v4u qraw[4], zraw[2][4];
    {
        const bf16* qp = P + (size_t)(row0 + 64 * (wid & 1) + r32) * D_P + C_Q + h * 64 + hi * 8;
#pragma unroll
        for (int d0 = 0; d0 < 4; ++d0) qraw[d0] = *(const GAS v4u*)(qp + d0 * 16);
#pragma unroll
        for (int i = 0; i < 4; ++i) { const int r = 8 * i + (lane >> 3), c = (lane & 7) ^ ((r >> 1) & 7);
            dma16(P + (size_t)(row0 + 64 * (wid & 1) + 32 + r) * D_P + C_Q + h * 64 + c * 8, lds + P2_B + wid * 8192 + (32 + 8 * i) * 128); }
    }
    const f32x4 kw0 = *(const GAS f32x4*)(knw + (tid & 7) * 8), kw1 = *(const GAS f32x4*)(knw + (tid & 7) * 8 + 4);
    const float sink2 = sinks[h] * LOG2E;
    for (int i = tid; i < 4 * 192; i += 512) {
        const int gg = i / 192, dist = (i % 192) - 32;
        float v = NEG_BIG;
        if (dist >= 0 && dist < WINDOW) v = relb[t5_bucket(dist) * N_HEADS + kvh * 4 + gg] * LOG2E;
        ((LAS float*)(lds + AT_TAB))[i] = v;
    }
    if (tid < 64) ((LAS float*)(lds + AT_QNW))[tid] = qnw[tid] * (0.125f * LOG2E);
#pragma unroll
    for (int i = 0; i < 4; ++i) {
        const int idx = tid + 512 * i, s = idx >> 3, ch = idx & 7;
        const bool valid = (nb > 0) || (s >= 128);
        float kf[8];
#pragma unroll
        for (int j = 0; j < 4; ++j) { kf[2 * j] = bf_lo(kraw[i][j]); kf[2 * j + 1] = bf_hi(kraw[i][j]); }
        float ss = 0.f;
#pragma unroll
        for (int j = 0; j < 8; ++j) ss += kf[j] * kf[j];
        ss += __shfl_xor(ss, 1); ss += __shfl_xor(ss, 2); ss += __shfl_xor(ss, 4);
        const float rs = valid ? 1.0f / sqrtf(ss * (1.0f / 64.0f) + EPS) : 0.f;
        v4u kn; kn.x = pk2(kf[0] * rs * kw0.x, kf[1] * rs * kw0.y); kn.y = pk2(kf[2] * rs * kw0.z, kf[3] * rs * kw0.w);
        kn.z = pk2(kf[4] * rs * kw1.x, kf[5] * rs * kw1.y); kn.w = pk2(kf[6] * rs * kw1.z, kf[7] * rs * kw1.w);
        *(LAS v4u*)(lds + AT_K + s * 128 + ((ch ^ ((s >> 1) & 7)) << 4)) = kn;
        *(LAS v4u*)(lds + AT_V + (ch >> 2) * AT_VPLANE + s * 64 + (ch & 3) * 16) = valid ? vraw[i] : (v4u){0u, 0u, 0u, 0u};
    }
    __syncthreads();
    const LAS float* tab = (const LAS float*)(lds + AT_TAB) + g * 192;
    LAS unsigned char* stg = lds + P2_B + wid * 8192;
    const int vlane = ((lane >> 4) & 1) * 32 + (lane & 3) * 8 + (4 * hi + ((lane & 15) >> 2)) * 64;
#pragma unroll
    for (int qq = 0; qq < 2; ++qq) {
        const int a = (wid & 1) * 2 + qq;
        if (qq == 1) {
#pragma unroll
            for (int d0 = 0; d0 < 4; ++d0) qraw[d0] = *(const LAS v4u*)(stg + (32 + r32) * 128 + (((2 * d0 + hi) ^ ((r32 >> 1) & 7)) << 4));
        }
        float ss = 0.f;
#pragma unroll
        for (int d0 = 0; d0 < 4; ++d0)
#pragma unroll
            for (int j = 0; j < 4; ++j) { const float lo = bf_lo(qraw[d0][j]), hv = bf_hi(qraw[d0][j]); ss += lo * lo + hv * hv; }
        ss = hsum32(ss);
        const float qs = 1.0f / sqrtf(ss * (1.0f / 64.0f) + EPS);
        bf16x8 qr[4];
#pragma unroll
        for (int d0 = 0; d0 < 4; ++d0) {
            const f32x4 w0 = *(const LAS f32x4*)(lds + AT_QNW + (d0 * 16 + hi * 8) * 4), w1 = *(const LAS f32x4*)(lds + AT_QNW + (d0 * 16 + hi * 8 + 4) * 4);
            const v4u q4 = qraw[d0];
            v4u t; t.x = pk2(bf_lo(q4.x) * qs * w0.x, bf_hi(q4.x) * qs * w0.y); t.y = pk2(bf_lo(q4.y) * qs * w0.z, bf_hi(q4.y) * qs * w0.w);
            t.z = pk2(bf_lo(q4.z) * qs * w1.x, bf_hi(q4.z) * qs * w1.y); t.w = pk2(bf_lo(q4.w) * qs * w1.z, bf_hi(q4.w) * qs * w1.w);
            qr[d0] = __builtin_bit_cast(bf16x8, t);
        }
        f32x16 S[5];
#pragma unroll
        for (int t = 0; t < 5; ++t) {
            asm volatile("" ::: "memory");
            const int st = a + t;
            const bool dead = (nb == 0) && (st < 4);
#pragma unroll
            for (int r = 0; r < 16; ++r) { const float tv = tab[r32 + 160 - 32 * t - crow(r, hi)]; S[t][r] = dead ? NEG_BIG : tv; }
            const int key = 32 * st + r32;
            const LAS unsigned char* kp = lds + AT_K + key * 128;
            const int sw = (key >> 1) & 7;
#pragma unroll
            for (int d0 = 0; d0 < 4; ++d0) {
                const bf16x8 kf = *(const LAS bf16x8*)(kp + (((2 * d0 + hi) ^ sw) << 4));
                S[t] = __builtin_amdgcn_mfma_f32_32x32x16_bf16(kf, qr[d0], S[t], 0, 0, 0);
            }
        }
        float mx = sink2;
#pragma unroll
        for (int t = 0; t < 5; ++t)
#pragma unroll
            for (int r = 0; r < 16; ++r) mx = fmaxf(mx, S[t][r]);
        mx = hmax32(mx);
        float l = 0.f;
#pragma unroll
        for (int t = 0; t < 5; ++t)
#pragma unroll
            for (int r = 0; r < 16; ++r) { S[t][r] = __builtin_amdgcn_exp2f(S[t][r] - mx); l += S[t][r]; }
        l = hsum32(l);
        l += __builtin_amdgcn_exp2f(sink2 - mx);
        const float rl = 1.0f / l;
        f32x16 O[2];
#pragma unroll
        for (int d0 = 0; d0 < 2; ++d0)
#pragma unroll
            for (int r = 0; r < 16; ++r) O[d0][r] = 0.f;
#pragma unroll
        for (int t = 0; t < 5; ++t) {
            const int st = a + t;
#pragma unroll
            for (int s = 0; s < 2; ++s) {
                v4u pw;
#pragma unroll
                for (int j = 0; j < 4; ++j) pw[j] = pk2(S[t][8 * s + 2 * j], S[t][8 * s + 2 * j + 1]);
                const bf16x8 pf = __builtin_bit_cast(bf16x8, pw);
#pragma unroll
                for (int d0 = 0; d0 < 2; ++d0) {
                    const LAS unsigned char* vp = lds + AT_V + d0 * AT_VPLANE + (32 * st + 16 * s) * 64 + vlane;
                    const s16x4 lo = vtr(vp), hv = vtr(vp + 8 * 64);
                    const bf16x8 vf = (bf16x8){lo[0], lo[1], lo[2], lo[3], hv[0], hv[1], hv[2], hv[3]};
                    O[d0] = __builtin_amdgcn_mfma_f32_32x32x16_bf16(vf, pf, O[d0], 0, 0, 0);
                }
            }
        }
#pragma unroll
        for (int d0 = 0; d0 < 2; ++d0)
#pragma unroll
            for (int gq = 0; gq < 4; ++gq) {
                u32x2 w; w.x = pk2(O[d0][4 * gq] * rl, O[d0][4 * gq + 1] * rl); w.y = pk2(O[d0][4 * gq + 2] * rl, O[d0][4 * gq + 3] * rl);
                *(LAS u32x2*)(stg + (32 * qq + r32) * 128 + (((4 * d0 + gq) ^ (r32 & 7)) << 4) + 8 * hi) = w;
            }
    }
#pragma unroll
    for (int q2 = 0; q2 < 2; ++q2)
#pragma unroll
        for (int i = 0; i < 4; ++i) zraw[q2][i] = *(const GAS v4u*)(P + (size_t)(row0 + 32 * ((wid & 1) * 2 + q2) + 8 * i + (lane >> 3)) * D_P + C_ZA + h * 64 + (lane & 7) * 8);
    __syncthreads();
    const int r0 = unit * 64, t0 = r0 % SEQ;
#pragma unroll
    for (int i = 0; i < 12; ++i) {
        const int row = wid + 8 * i;
        if (row < CV_UROWS) {
            if (t0 + row - (CONVW - 1) >= 0) dma16(P + (size_t)(r0 + row - (CONVW - 1)) * D_P + C_U + lane * 8, lds + CV_U + row * 1024);
            else *(LAS v4u*)(lds + CV_U + row * 1024 + lane * 16) = (v4u){0u, 0u, 0u, 0u};
        }
    }
    if (xpf) {
#pragma unroll
        for (int i = 0; i < 4; ++i) prefetch_line_asm(xpf + (size_t)(64 * i) * D_MODEL, (unsigned)__builtin_amdgcn_readfirstlane((int)(unsigned)(size_t)(lds + PF_SCRATCH)));
    }
#pragma unroll
    for (int qq = 0; qq < 2; ++qq) {
        const int a = (wid & 1) * 2 + qq;
#pragma unroll
        for (int i = 0; i < 4; ++i) {
            const int row = 8 * i + (lane >> 3), c = lane & 7;
            const v4u ov = *(const LAS v4u*)(stg + (32 * qq + row) * 128 + ((c ^ (row & 7)) << 4));
            const v4u zv = zraw[qq][i];
            v4u yv;
#pragma unroll
            for (int j = 0; j < 4; ++j) yv[j] = pk2(bf_lo(ov[j]) * silu_f(bf_lo(zv[j])), bf_hi(ov[j]) * silu_f(bf_hi(zv[j])));
            *(GAS v4u*)(Y + (size_t)(row0 + 32 * a + row) * D_MODEL + h * 64 + c * 8) = yv;
        }
    }
    int ch = tid; asm volatile("" : "+v"(ch));
    float w[CONVW];
#pragma unroll
    for (int j = 0; j < CONVW; ++j) w[j] = dww[j * D_CONV + ch];
    const float cbias = dwb[ch], lw = lnw[ch], lb = lnb[ch];
    __syncthreads();
#pragma unroll
    for (int i = 0; i < 8; ++i) { const int row = wid + 8 * i; dma16_asm(P + (size_t)(r0 + row) * D_P + C_ZC + lane * 8, (unsigned)__builtin_amdgcn_readfirstlane((int)(unsigned)(size_t)(lds + P2_B + row * 1024))); }
    float acc[CONVW], yv[64];
#pragma unroll
    for (int j = 0; j < CONVW; ++j) acc[j] = 0.f;
    const LAS unsigned short* ub = (const LAS unsigned short*)(lds + CV_U) + ch;
    ConvStep<0>::run(acc, yv, w, ub, cbias);
    float sv[64];
#pragma unroll
    for (int i = 0; i < 64; ++i) sv[i] = yv[i];
    const float tot1 = wave_transpose_sum64(sv, lane);
#pragma unroll
    for (int i = 0; i < 64; ++i) sv[i] = yv[i] * yv[i];
    const float tot2 = wave_transpose_sum64(sv, lane);
    asm volatile("s_waitcnt vmcnt(0)" ::: "memory");
    __syncthreads();
    ((LAS float*)(lds + CV_PART))[wid * 128 + lane] = tot1; ((LAS float*)(lds + CV_PART))[wid * 128 + 64 + lane] = tot2;
    __syncthreads();
    if (tid < 64) {
        const LAS float* pp = (const LAS float*)(lds + CV_PART) + tid;
        float s1 = 0.f, s2 = 0.f;
#pragma unroll
        for (int wv = 0; wv < 8; ++wv) { s1 += pp[wv * 128]; s2 += pp[wv * 128 + 64]; }
        const float mu = s1 * (1.0f / D_CONV), var = fmaxf(s2 * (1.0f / D_CONV) - mu * mu, 0.f);
        ((LAS f32x2*)(lds + CV_STAT))[tid] = (f32x2){mu, 1.0f / sqrtf(var + LN_EPS)};
    }
    __syncthreads();
    const LAS unsigned short* zb = (const LAS unsigned short*)(lds + P2_B) + ch;
    bf16* yp = Y + (size_t)r0 * D_MODEL + D_ATTN + ch;
#pragma unroll
    for (int i = 0; i < 64; ++i) {
        const f32x2 st = ((const LAS f32x2*)(lds + CV_STAT))[i];
        const float z = __builtin_bit_cast(float, (unsigned)zb[i * 512] << 16);
        const float yn = (yv[i] - st.x) * st.y * lw + lb;
        yp[(size_t)i * D_MODEL] = (bf16)(pk2(silu_f(yn) * silu_f(z), 0.f) & 0xffffu);
    }
}

#define REP0 1
#define REP1 1
#define REP2 1
#define REP3 1
#define EXTRA_BARS 0
#define PREFETCH_X 0
struct Args { const float* in[12]; float* out; unsigned char* ws; int ph_lo, ph_hi, p2mask, pad; };
__global__ void __launch_bounds__(NWAVES * 64, 2) hymba_fwd(Args args) {
    extern __shared__ __attribute__((aligned(16))) unsigned char lds_raw[];
    LAS unsigned char* lds = (LAS unsigned char*)lds_raw;
    volatile LAS unsigned* MISC = (volatile LAS unsigned*)(lds + MISC_OFF);
    const int tid = threadIdx.x, lane = tid & 63, wave = __builtin_amdgcn_readfirstlane(tid >> 6);
    const int G = gridDim.x; const int bx = blockIdx.x;
    const int vcu = (G % 8 == 0) ? (bx % 8) * (G / 8) + bx / 8 : bx;
    unsigned char* ws = args.ws;
    gu32* ctl = (gu32*)(ws + WS_CTL);
    const float* x = args.in[0]; const float* norm_w = args.in[1]; const float* w_in = args.in[2]; const float* qnw = args.in[3]; const float* knw = args.in[4];
    const float* sinks = args.in[5]; const float* dww = args.in[6]; const float* dwb = args.in[7]; const float* lnw = args.in[8]; const float* lnb = args.in[9];
    const float* w_out = args.in[10]; const float* relb = args.in[11];
    bf16* WIN = (bf16*)(ws + WS_WIN); bf16* WOUT = (bf16*)(ws + WS_WOUT); bf16* XN = (bf16*)(ws + WS_XN); bf16* P = (bf16*)(ws + WS_P); bf16* Y = (bf16*)(ws + WS_Y);
    for (int u = tid; u < (LDS_BYTES - RING_BYTES) / 4; u += NWAVES * 64) ((LAS unsigned*)(lds + RING_BYTES))[u] = 0u;
    __syncthreads();
    const int lo = args.ph_lo, hi = args.ph_hi;
    const bool use_bar = (hi - lo) > 1;
    XcdBarrier bar; bar.bar = (unsigned*)(ctl + CW_BAR); bar.x = 0; bar.st = nullptr;
    if (use_bar) bar = xcd_barrier_post((unsigned*)(ctl + CW_BAR), MISC + 8);
#define IN(k) (lo <= (k) && (k) < hi)
#define BOTH(k) (IN(k) && IN((k) + 1))
    if (IN(0)) {
        for (int rep = 0; rep < REP0; ++rep) {
        p0_prologue(lds, vcu * NWAVES + wave, G * NWAVES, wave, lane, x, norm_w, w_in, w_out, WIN, WOUT, XN);
        if (BOTH(0)) xcd_barrier(bar);
        }
        for (int rep = 0; rep < EXTRA_BARS; ++rep) xcd_barrier(bar);
    }
    if (IN(1)) {
        for (int rep = 0; rep < REP1; ++rep) {
        pg8::Gemm g{XN, WIN, M, D_IN, D_MODEL}; pg8::StaticOrder S; S.init(M, D_IN, G, bx);
        pg8::EpiProj E{P};
        pg8::gemm_phase<pg8::EpiProj, pg8::StaticOrder, PG8_ALIGN, PG8_SP2>(lds, g, S, E);
        if (BOTH(1)) xcd_barrier(bar);
        }
    }
    if (IN(2)) {
        for (int rep = 0; rep < REP2; ++rep) {
        for (int u = vcu; u < 256; u += G) {
            int t_ = tid; asm volatile("" : "+v"(t_));
            const float* xpf = nullptr;
            if (PREFETCH_X && u == vcu) { pg8::StaticOrder S3; S3.init(M, D_MODEL, G, bx); pg8::Unit u3; if (S3.next(0, u3)) xpf = x + (size_t)(u3.pm * 256 + (t_ >> 3)) * D_MODEL + u3.pn * 256 + (t_ & 7) * 32; }
            p2_unit(lds, u, t_, t_ & 63, wave, P, Y, qnw, knw, sinks, relb, dww, dwb, lnw, lnb, xpf);
            __syncthreads();
        }
        if (BOTH(2)) xcd_barrier(bar);
        }
    }
    if (IN(3)) {
        for (int rep = 0; rep < REP3; ++rep) {
        pg8::Gemm g{Y, WOUT, M, D_MODEL, D_MODEL}; pg8::StaticOrder S; S.init(M, D_MODEL, G, bx);
        pg8::EpiResF32 E{args.out, x, D_MODEL};
        pg8::gemm_phase<pg8::EpiResF32, pg8::StaticOrder, PG8_ALIGN, PG8_SP2>(lds, g, S, E);
        }
    }
#undef IN
#undef BOTH
}

extern "C" void kernel_launch(void* const* d_in, const int* in_sizes, int n_in, void* d_out, int out_size, void* d_ws, size_t ws_size, hipStream_t stream) {
    static int grid = 0;
    if (grid == 0) {
        if (n_in != 12 || in_sizes[0] != M * D_MODEL || out_size != M * D_MODEL || ws_size < WS_END) { fprintf(stderr, "kernel_launch: unexpected shapes; nothing launched\n"); grid = -1; return; }
        int dev = 0, cus = 0, per_cu = 0;
        if (hipGetDevice(&dev) != hipSuccess || hipDeviceGetAttribute(&cus, hipDeviceAttributeMultiprocessorCount, dev) != hipSuccess) { fprintf(stderr, "kernel_launch: device query failed\n"); grid = -1; return; }
        if (hipFuncSetAttribute((const void*)hymba_fwd, hipFuncAttributeMaxDynamicSharedMemorySize, LDS_BYTES) != hipSuccess) { fprintf(stderr, "kernel_launch: hipFuncSetAttribute failed\n"); grid = -1; return; }
        if (hipOccupancyMaxActiveBlocksPerMultiprocessor(&per_cu, (const void*)hymba_fwd, NWAVES * 64, LDS_BYTES) != hipSuccess || per_cu < 1) { fprintf(stderr, "kernel_launch: occupancy query says %d blocks per CU; nothing launched\n", per_cu); (void)hipGetLastError(); grid = -1; return; }
        grid = cus;
    }
    if (grid < 0) return;
    if (hipMemsetAsync((unsigned char*)d_ws + WS_CTL, 0, CTL_ZERO_BYTES, stream) != hipSuccess) { fprintf(stderr, "kernel_launch: memset failed\n"); return; }
    Args a{};
    for (int i = 0; i < 12; ++i) a.in[i] = (const float*)d_in[i];
    a.out = (float*)d_out; a.ws = (unsigned char*)d_ws; a.ph_lo = 0; a.ph_hi = 4; a.p2mask = 3;
    hipLaunchKernelGGL(hymba_fwd, dim3(grid), dim3(NWAVES * 64), LDS_BYTES, stream, a);
}
```
